# Optimizing an MI355X kernel written in HIP

```python
import jax, jax.numpy as jnp
from jax import lax
import numpy as np

D_MODEL = 1024
BATCH = 2
SEQ = 8192
DEPTH = 1
DEC_BATCH = 32
DEC_SEQ = 64
PAST_LEN = 4096

CHUNK = 64
SUB = 16
N_MEM = 256
EPS = 1e-6
ROPE_BASE = 10000.0
HG_H = 8
HG_DK = 128
HG_DV = 128
HG_KW = HG_H * HG_DK
HG_W = HG_H * HG_DV
RT_H = 4
RT_DK = 64
RT_DV = 128
RT_QK = RT_H * RT_DK
RT_W = RT_H * RT_DV
XA_H = 4
XA_DH = 128
XA_W = XA_H * XA_DH
D_MIX = HG_W + RT_W + XA_W
SPLIT_SIZES = (HG_KW, HG_KW, HG_W, HG_W, RT_QK, RT_QK, RT_W, RT_W, XA_W, XA_W)
D_IN = 2 * HG_KW + 2 * HG_W + 2 * RT_QK + 2 * RT_W + 2 * XA_W

kernel_name = "hgrn2_retention_memxattn_parallel_stream_step"


def _split_points():
    pts, acc = [], 0
    for s in SPLIT_SIZES[:-1]:
        acc += s
        pts.append(acc)
    return pts


def rms_norm(x, g):
    x32 = x.astype(jnp.float32)
    r = x32 * lax.rsqrt(jnp.mean(x32 * x32, axis=-1, keepdims=True) + EPS)
    return r * g.astype(jnp.float32)


def head_rms_norm(o, g):
    h, d = o.shape[-2], o.shape[-1]
    r = o * lax.rsqrt(jnp.mean(o * o, axis=-1, keepdims=True) + EPS)
    return r * g.astype(jnp.float32).reshape(h, d)


def head_group_norm(o, g):
    h, d = o.shape[-2], o.shape[-1]
    mu = jnp.mean(o, axis=-1, keepdims=True)
    c = o - mu
    r = c * lax.rsqrt(jnp.mean(c * c, axis=-1, keepdims=True) + EPS)
    return r * g.astype(jnp.float32).reshape(h, d)


def apply_rope(x, pos):
    half = x.shape[-1] // 2
    inv_freq = ROPE_BASE ** (-jnp.arange(half, dtype=jnp.float32) / half)
    ang = pos.astype(jnp.float32)[:, None] * inv_freq[None, :]
    cos, sin = jnp.cos(ang)[None, :, None, :], jnp.sin(ang)[None, :, None, :]
    x1, x2 = x[..., :half], x[..., half:]
    return jnp.concatenate([x1 * cos - x2 * sin, x1 * sin + x2 * cos], axis=-1)


def hgrn2_chunkwise(q, k, v, g, s0):
    b, t, h, dk = q.shape
    dv = v.shape[-1]
    nc, nsb = t // CHUNK, CHUNK // SUB

    def blk(a):
        return a.reshape(b, nc, nsb, SUB, h, a.shape[-1]).transpose(0, 4, 1, 2, 3, 5)

    q, k, v, g = blk(q), blk(k), blk(v), blk(g)
    gc = jnp.cumsum(g.reshape(b, h, nc, CHUNK, dk), axis=3).reshape(b, h, nc, nsb, SUB, dk)
    g_end = gc[..., -1, :]
    g_ref = jnp.concatenate([jnp.zeros_like(g_end[:, :, :, :1]), g_end[:, :, :, :-1]], axis=3)
    g_chunk = g_end[:, :, :, -1]
    q_ref = q * jnp.exp(gc - g_ref[..., None, :])
    k_ref = k * jnp.exp(g_ref[..., None, :] - gc)
    causal = jnp.tril(jnp.ones((SUB, SUB), dtype=bool))
    a_diag = jnp.where(causal, jnp.einsum('bhcaid,bhcajd->bhcaij', q_ref, k_ref), 0.0)
    o = jnp.einsum('bhcaij,bhcajv->bhcaiv', a_diag, v)
    k_end = k * jnp.exp(g_end[..., None, :] - gc)
    sb_lower = jnp.arange(nsb)[:, None] > jnp.arange(nsb)[None, :]
    mid = jnp.exp(jnp.where(sb_lower[..., None],
                            g_ref[:, :, :, :, None, :] - g_end[:, :, :, None, :, :], -jnp.inf))
    a_off = jnp.einsum('bhcaid,bhcaed,bhcejd->bhcaeij', q_ref, mid, k_end)
    o = o + jnp.einsum('bhcaeij,bhcejv->bhcaiv', a_off, v)
    k_chunk = k * jnp.exp(g_chunk[:, :, :, None, None, :] - gc)
    ds = jnp.einsum('bhcaid,bhcaiv->bhcdv', k_chunk, v)

    def step(s, inp):
        decay, d = inp
        return decay[..., None] * s + d, s

    s_fin, s_starts = lax.scan(step, s0, (jnp.moveaxis(jnp.exp(g_chunk), 2, 0), jnp.moveaxis(ds, 2, 0)))
    s_starts = jnp.moveaxis(s_starts, 0, 2)
    o = o + jnp.einsum('bhcaid,bhcdv->bhcaiv', q * jnp.exp(gc), s_starts)
    o = o.transpose(0, 2, 3, 4, 1, 5).reshape(b, t, h, dv)
    return o, s_fin


def retention_chunkwise(q, k, v, r0, chunk):
    b, t, h, dk = q.shape
    dv = v.shape[-1]
    nc = t // chunk
    log_gamma = jnp.log1p(-jnp.exp2(-5.0 - jnp.arange(h, dtype=jnp.float32)))
    pos = jnp.arange(chunk, dtype=jnp.float32)
    lg = log_gamma[:, None]
    intra = jnp.exp(lg[..., None] * jnp.abs(pos[:, None] - pos[None, :]))
    q_decay = jnp.exp(lg * (pos + 1.0))
    k_decay = jnp.exp(lg * (chunk - 1.0 - pos))
    chunk_decay = jnp.exp(log_gamma * chunk)
    qc = q.reshape(b, nc, chunk, h, dk)
    kc = k.reshape(b, nc, chunk, h, dk)
    vc = v.reshape(b, nc, chunk, h, dv)
    scores = jnp.einsum('bcihd,bcjhd->bchij', qc, kc) * intra
    o = jnp.einsum('bchij,bcjhv->bcihv', scores, vc)
    dr = jnp.einsum('bcjhd,hj,bcjhv->bchdv', kc, k_decay, vc)

    def step(r, d):
        return chunk_decay[:, None, None] * r + d, r

    r_fin, r_starts = lax.scan(step, r0, jnp.moveaxis(dr, 1, 0))
    r_starts = jnp.moveaxis(r_starts, 0, 1)
    o = o + jnp.einsum('bcihd,hi,bchdv->bcihv', qc, q_decay, r_starts)
    return o.reshape(b, t, h, dv), r_fin


def memory_kv(mem, mem_norm_g, w_mem_k, w_mem_v):
    m = rms_norm(mem, mem_norm_g)
    b = mem.shape[0]
    mk = (m @ w_mem_k.astype(jnp.float32)).reshape(b, N_MEM, XA_H, XA_DH)
    mv = (m @ w_mem_v.astype(jnp.float32)).reshape(b, N_MEM, XA_H, XA_DH)
    return mk, mv


def mixer_layer(x, pos, s_hg, s_rt, mem_k, mem_v, norm_g, w_in, lb, hg_norm_g, rt_norm_g, w_out):
    b, t, _ = x.shape
    f32 = jnp.float32
    h = rms_norm(x, norm_g)
    proj = h @ w_in.astype(f32)
    hg_q, hg_f, hg_i, hg_gate, rt_q, rt_k, rt_v, rt_gate, xa_q, xa_gate = jnp.split(proj, _split_points(), axis=-1)

    lb = lb.astype(f32)
    sig = jax.nn.sigmoid(hg_f)
    log_f = jnp.log(lb + (1.0 - lb) * sig)
    k_in = (1.0 - lb) * jax.nn.sigmoid(-hg_f)
    qa = jax.nn.silu(hg_q).reshape(b, t, HG_H, HG_DK)
    ka = k_in.reshape(b, t, HG_H, HG_DK)
    ga = log_f.reshape(b, t, HG_H, HG_DK)
    va = hg_i.reshape(b, t, HG_H, HG_DV)
    pad = (-t) % CHUNK
    pw = ((0, 0), (0, pad), (0, 0), (0, 0))
    o_hg, s_hg_new = hgrn2_chunkwise(jnp.pad(qa, pw), jnp.pad(ka, pw), jnp.pad(va, pw), jnp.pad(ga, pw),
                                     s_hg.astype(f32))
    o_hg = head_rms_norm(o_hg[:, :t], hg_norm_g).reshape(b, t, HG_W) * jax.nn.silu(hg_gate)

    rq = apply_rope(rt_q.reshape(b, t, RT_H, RT_DK), pos)
    rk = apply_rope(rt_k.reshape(b, t, RT_H, RT_DK), pos) * (RT_DK ** -0.5)
    rv = rt_v.reshape(b, t, RT_H, RT_DV)
    o_rt, s_rt_new = retention_chunkwise(rq, rk, rv, s_rt.astype(f32), min(CHUNK, t))
    o_rt = head_group_norm(o_rt, rt_norm_g).reshape(b, t, RT_W) * jax.nn.silu(rt_gate)

    xq = xa_q.reshape(b, t, XA_H, XA_DH) * (XA_DH ** -0.5)
    att = jax.nn.softmax(jnp.einsum('bthd,bmhd->bhtm', xq, mem_k.astype(f32)), axis=-1)
    o_xa = jnp.einsum('bhtm,bmhd->bthd', att, mem_v.astype(f32)).reshape(b, t, XA_W) * jax.nn.silu(xa_gate)

    mixed = jnp.concatenate([o_hg, o_rt, o_xa], axis=-1)
    out = x.astype(f32) + mixed @ w_out.astype(f32)
    return out, s_hg_new, s_rt_new


def setup_inputs(seed: int = 0) -> dict:
    key = jax.random.key(seed)
    ks = jax.random.split(key, 18)
    f32 = jnp.float32

    def nrm(k, shape, scale=1.0):
        return scale * jax.random.normal(k, shape, f32)

    return {
        "x_prompt": nrm(ks[0], (BATCH, SEQ, D_MODEL)),
        "x_sample": nrm(ks[1], (DEC_BATCH, DEC_SEQ, D_MODEL)),
        "mem_prompt": nrm(ks[2], (BATCH, N_MEM, D_MODEL)),
        "state_hgrn": nrm(ks[3], (DEPTH, DEC_BATCH, HG_H, HG_DK, HG_DV)),
        "state_ret": nrm(ks[4], (DEPTH, DEC_BATCH, RT_H, RT_DK, RT_DV), 4.0),
        "cache_mem_k": nrm(ks[5], (DEPTH, DEC_BATCH, N_MEM, XA_H, XA_DH)),
        "cache_mem_v": nrm(ks[6], (DEPTH, DEC_BATCH, N_MEM, XA_H, XA_DH)),
        "norm_g": 1.0 + nrm(ks[7], (DEPTH, D_MODEL), 0.02),
        "w_in": nrm(ks[8], (DEPTH, D_MODEL, D_IN), D_MODEL ** -0.5),
        "lb_logits": nrm(ks[9], (DEPTH + 1, HG_KW), 0.1),
        "hg_norm_g": 1.0 + nrm(ks[10], (DEPTH, HG_W), 0.02),
        "rt_norm_g": 1.0 + nrm(ks[11], (DEPTH, RT_W), 0.02),
        "mem_norm_g": 1.0 + nrm(ks[12], (DEPTH, D_MODEL), 0.02),
        "w_mem_k": nrm(ks[13], (DEPTH, D_MODEL, XA_W), D_MODEL ** -0.5),
        "w_mem_v": nrm(ks[14], (DEPTH, D_MODEL, XA_W), D_MODEL ** -0.5),
        "w_out": nrm(ks[15], (DEPTH, D_MIX, D_MODEL), D_MIX ** -0.5),
        "final_norm_g": 1.0 + nrm(ks[16], (D_MODEL,), 0.02),
    }


def reference(x_prompt, x_sample, mem_prompt, state_hgrn, state_ret, cache_mem_k, cache_mem_v,
              norm_g, w_in, lb_logits, hg_norm_g, rt_norm_g, mem_norm_g, w_mem_k, w_mem_v, w_out,
              final_norm_g):
    f32 = jnp.float32
    bp, tp, _ = x_prompt.shape
    ts = x_sample.shape[1]
    pos_p = jnp.arange(tp)
    pos_s = PAST_LEN + jnp.arange(ts)
    lb_all = jnp.cumsum(jax.nn.softmax(lb_logits.astype(f32), axis=0), axis=0)
    hp, hs = x_prompt, x_sample
    hg_p, rt_p, mk_p, mv_p, hg_s, rt_s = [], [], [], [], [], []
    for l in range(DEPTH):
        mk, mv = memory_kv(mem_prompt, mem_norm_g[l], w_mem_k[l], w_mem_v[l])
        hp, shg, srt = mixer_layer(hp, pos_p, jnp.zeros((bp, HG_H, HG_DK, HG_DV), f32),
                                   jnp.zeros((bp, RT_H, RT_DK, RT_DV), f32), mk, mv,
                                   norm_g[l], w_in[l], lb_all[l], hg_norm_g[l], rt_norm_g[l], w_out[l])
        hg_p.append(shg); rt_p.append(srt); mk_p.append(mk); mv_p.append(mv)
        hs, shg2, srt2 = mixer_layer(hs, pos_s, state_hgrn[l], state_ret[l], cache_mem_k[l], cache_mem_v[l],
                                     norm_g[l], w_in[l], lb_all[l], hg_norm_g[l], rt_norm_g[l], w_out[l])
        hg_s.append(shg2); rt_s.append(srt2)
    dt = x_prompt.dtype
    y_prompt = rms_norm(hp, final_norm_g).astype(dt)
    y_sample = rms_norm(hs, final_norm_g).astype(x_sample.dtype)
    new_state_hgrn_prompt = jnp.stack(hg_p).astype(dt)
    new_state_ret_prompt = jnp.stack(rt_p).astype(dt)
    new_mem_k_prompt = jnp.stack(mk_p).astype(dt)
    new_mem_v_prompt = jnp.stack(mv_p).astype(dt)
    new_state_hgrn_sample = jnp.stack(hg_s).astype(state_hgrn.dtype)
    new_state_ret_sample = jnp.stack(rt_s).astype(state_ret.dtype)
    return (y_prompt, y_sample, new_state_hgrn_prompt, new_state_ret_prompt, new_mem_k_prompt, new_mem_v_prompt,
            new_state_hgrn_sample, new_state_ret_sample)
```

```cpp
#include <hip/hip_runtime.h>
#include <cstdio>
#include <cstdint>

typedef unsigned short bf16_t;

constexpr int D_MODEL = 1024, BATCH = 2, SEQ = 8192, DEC_BATCH = 32, DEC_SEQ = 64, PAST_LEN = 4096, CHUNK = 64, N_MEM = 256;
constexpr int HG_H = 8, HG_DK = 128, HG_DV = 128, RT_H = 4, RT_DK = 64, RT_DV = 128, XA_H = 4, XA_DH = 128;
constexpr int D_IN = 6656, D_MIX = 2048;
constexpr int MP = BATCH * SEQ;
constexpr int MS = DEC_BATCH * DEC_SEQ;
constexpr int M = MP + MS;
constexpr int MMEM = BATCH * N_MEM;
constexpr int NSEQ = BATCH + DEC_BATCH;
constexpr float EPS = 1e-6f;
constexpr int NCG = 4;
constexpr int NG = SEQ / CHUNK / NCG;

constexpr size_t MiB = 1u << 20;
constexpr size_t WS_CTL = 0, CTL_ZERO_BYTES = 1 * MiB;
constexpr size_t WS_HQ = 1 * MiB, WS_HF = 37 * MiB, WS_HI = 73 * MiB, WS_MIX = 109 * MiB, WS_RQ = 181 * MiB, WS_RK = 190 * MiB, WS_RV = 199 * MiB, WS_XQ = 217 * MiB;
constexpr size_t WS_WT = 235 * MiB, WS_WOT = 250 * MiB, WS_ROPE = 254 * MiB, WS_END = 256 * MiB;
constexpr size_t O_YP = 0, O_YS = (size_t)MP * D_MODEL, O_HGP = O_YS + (size_t)MS * D_MODEL, O_RTP = O_HGP + (size_t)BATCH * HG_H * HG_DK * HG_DV,
                 O_MKP = O_RTP + (size_t)BATCH * RT_H * RT_DK * RT_DV, O_MVP = O_MKP + (size_t)BATCH * N_MEM * 512, O_HGS = O_MVP + (size_t)BATCH * N_MEM * 512,
                 O_RTS = O_HGS + (size_t)DEC_BATCH * HG_H * HG_DK * HG_DV, O_END = O_RTS + (size_t)DEC_BATCH * RT_H * RT_DK * RT_DV;
constexpr size_t OB_XN = 0;
constexpr size_t OB_GSH = 0;
constexpr size_t OB_GSR = OB_GSH + (size_t)BATCH * NG * HG_H * 128 * 128 * 4;
constexpr size_t OB_GDH = OB_GSR + (size_t)BATCH * NG * RT_H * 64 * 128 * 4;
constexpr size_t OB_SCR_END = OB_GDH + (size_t)BATCH * NG * HG_H * 128 * 4;
static_assert(OB_SCR_END <= (size_t)M * D_MODEL * 4, "group-state scratch fits the y region");

__device__ __forceinline__ unsigned f2bf(float f) { unsigned u = __builtin_bit_cast(unsigned, f); return (u + 0x7fffu + ((u >> 16) & 1u)) >> 16; }
__device__ __forceinline__ unsigned pk2(float lo, float hi) { return f2bf(lo) | (f2bf(hi) << 16); }
__device__ __forceinline__ float bf2f(bf16_t h) { return __builtin_bit_cast(float, (unsigned)h << 16); }
__device__ __forceinline__ float bflo(unsigned w) { return __builtin_bit_cast(float, w << 16); }
__device__ __forceinline__ float bfhi(unsigned w) { return __builtin_bit_cast(float, w & 0xffff0000u); }
__device__ __forceinline__ float silu_f(float x) { return x / (1.f + __expf(-x)); }

struct Ptrs {
    const float* in[17]; float* out; unsigned char* ws;
};
__device__ __forceinline__ bf16_t* wsb(const Ptrs& P, size_t off) { return (bf16_t*)(P.ws + off); }

struct Route { bf16_t* base; int pitch; int col; int act; };
__device__ __forceinline__ Route route_col(unsigned char* ws, int n) {
    Route r;
    if (n < 1024)      { r.base = (bf16_t*)(ws + WS_HQ);  r.pitch = 1024; r.col = n;               r.act = 1; }
    else if (n < 2048) { r.base = (bf16_t*)(ws + WS_HF);  r.pitch = 1024; r.col = n - 1024;        r.act = 0; }
    else if (n < 3072) { r.base = (bf16_t*)(ws + WS_HI);  r.pitch = 1024; r.col = n - 2048;        r.act = 0; }
    else if (n < 4096) { r.base = (bf16_t*)(ws + WS_MIX); r.pitch = 2048; r.col = n - 3072;        r.act = 1; }
    else if (n < 4352) { r.base = (bf16_t*)(ws + WS_RQ);  r.pitch = 256;  r.col = n - 4096;        r.act = 0; }
    else if (n < 4608) { r.base = (bf16_t*)(ws + WS_RK);  r.pitch = 256;  r.col = n - 4352;        r.act = 0; }
    else if (n < 5120) { r.base = (bf16_t*)(ws + WS_RV);  r.pitch = 512;  r.col = n - 4608;        r.act = 0; }
    else if (n < 5632) { r.base = (bf16_t*)(ws + WS_MIX); r.pitch = 2048; r.col = 1024 + n - 5120; r.act = 1; }
    else if (n < 6144) { r.base = (bf16_t*)(ws + WS_XQ);  r.pitch = 512;  r.col = n - 5632;        r.act = 0; }
    else               { r.base = (bf16_t*)(ws + WS_MIX); r.pitch = 2048; r.col = 1536 + n - 6144; r.act = 1; }
    return r;
}
__device__ __forceinline__ Route route_col(const Ptrs& P, int n) { return route_col(P.ws, n); }

__device__ __forceinline__ float wave_sum(float v) {
#pragma unroll
    for (int o = 1; o < 64; o <<= 1) v += __shfl_xor(v, o);
    return v;
}

namespace pg8 {
#define PG8_LAS __attribute__((address_space(3)))
typedef unsigned short bf16_t;
typedef short bf16x8 __attribute__((ext_vector_type(8)));
typedef float f32x4 __attribute__((ext_vector_type(4)));
typedef unsigned u32x4 __attribute__((ext_vector_type(4)));
constexpr int BM = 256, BK = 64, HALF = 128, HTB = HALF * BK * 2  , STAGE_BYTES = 8 * HTB, NXCD = 8, WGM = 8;

__host__ __device__ __forceinline__ int lds_byte(int r, int c) { const int st = (r >> 4) * 2 + (c >> 5), rr = r & 15, cc = c & 31, ob = rr * 64 + cc * 2; return st * 1024 + (ob ^ (((ob >> 9) & 1) << 5)); }
__host__ __device__ __forceinline__ void stage_rc(int b, int& R, int& C) { const int st = b / 1024, sb = b % 1024, swz = sb ^ (((sb >> 9) & 1) << 5); R = (st >> 1) * 16 + swz / 64; C = (st & 1) * 32 + (swz % 64) / 2; }
__host__ __device__ __forceinline__ int perm32(int rho) { const int n = rho >> 4, i = rho & 15; return 8 * (i >> 2) + 4 * n + (i & 3); }

struct Unit { int pm, pn; };
struct Gemm { const bf16_t* A; const bf16_t* Bt; int M, N, K; };

struct StaticOrder {
    int nM, nN, nwg, G, c;
    __host__ __device__ void init(int M, int N, int G_, int c_) { nM = M / BM; nN = N / BM; nwg = nM * nN; G = G_; c = c_; }
    __host__ __device__ bool next(int i, Unit& u) const {
        const long L = (long)i * G + c; if (L >= nwg) return false;
        int wgid = (int)L; { const int q = nwg / NXCD, r = nwg % NXCD, xcd = wgid % NXCD, off = wgid / NXCD; wgid = (xcd < r ? xcd * (q + 1) : r * (q + 1) + (xcd - r) * q) + off; }
        const int nig = WGM * nN, gid = wgid / nig, fm = gid * WGM, gsz = (nM - fm) < WGM ? (nM - fm) : WGM;
        u.pm = fm + ((wgid % nig) % gsz); u.pn = (wgid % nig) / gsz; return true;
    }
    __device__ __forceinline__ void a_ready(const Unit&) const {}
    __device__ __forceinline__ void done(const Unit&) const {}
};
struct ProjOrder {
    StaticOrder so; int G, c;
    __device__ void init(int G_, int c_) { so.init(M, D_IN, G_, c_); G = G_; c = c_; }
    __device__ bool next(int i, Unit& u) const {
        const long L = (long)i * G + c;
        if (L < so.nwg) return so.next(i, u);
        const int k = (int)(L - so.nwg); if (k >= 8) return false;
        u.pm = 72 + (k >> 2); u.pn = 26 + (k & 3); return true;
    }
    __device__ __forceinline__ void a_ready(const Unit&) const {}
    __device__ __forceinline__ void done(const Unit&) const {}
};
__device__ __forceinline__ float fast_silu(float v) { return v * __builtin_amdgcn_rcpf(1.f + __expf(-v)); }
__device__ __forceinline__ unsigned cvt_pk_bf16(float lo, float hi) { unsigned r; asm volatile("v_cvt_pk_bf16_f32 %0, %1, %2" : "=v"(r) : "v"(lo), "v"(hi)); return r; }
struct EpiProj {
    static constexpr bool PERM = true, AFTER_DRAIN = false;
    unsigned char* ws; float* out;
    __device__ __forceinline__ void operator()(const f32x4 (&acc)[2][2][4][2], const Unit& u, int wr, int wc, int fr, int fq) const {
        const int row0 = u.pm * BM + wr * 64 + fr;
        if (u.pn >= 26) {
            const int t = u.pn - 26;
            float* base = out + (t < 2 ? O_MKP : O_MVP) + (t & 1) * 256 + wc * 32 + 8 * fq;
            const int mrow0 = row0 - M;
#pragma unroll
            for (int ai = 0; ai < 2; ++ai)
#pragma unroll
                for (int m = 0; m < 4; ++m) { float* rowp = base + (size_t)(mrow0 + ai * HALF + m * 16) * 512;
#pragma unroll
                    for (int bj = 0; bj < 2; ++bj) { *(f32x4*)(rowp + bj * HALF) = acc[ai][bj][m][0]; *(f32x4*)(rowp + bj * HALF + 4) = acc[ai][bj][m][1]; } }
            return;
        }
        const Route r = route_col(ws, u.pn * BM);
        bf16_t* base = r.base + r.col + wc * 32 + 8 * fq;
#pragma unroll
        for (int ai = 0; ai < 2; ++ai)
#pragma unroll
            for (int m = 0; m < 4; ++m) { bf16_t* rowp = base + (size_t)(row0 + ai * HALF + m * 16) * r.pitch;
#pragma unroll
                for (int bj = 0; bj < 2; ++bj) { f32x4 v0 = acc[ai][bj][m][0], v1 = acc[ai][bj][m][1];
                    if (r.act) { v0 = (f32x4){fast_silu(v0[0]), fast_silu(v0[1]), fast_silu(v0[2]), fast_silu(v0[3])}; v1 = (f32x4){fast_silu(v1[0]), fast_silu(v1[1]), fast_silu(v1[2]), fast_silu(v1[3])}; }
                    u32x4 w; w.x = cvt_pk_bf16(v0[0], v0[1]); w.y = cvt_pk_bf16(v0[2], v0[3]); w.z = cvt_pk_bf16(v1[0], v1[1]); w.w = cvt_pk_bf16(v1[2], v1[3]);
                    *(u32x4*)(rowp + bj * HALF) = w; } }
    }
};
struct EpiOut {
    static constexpr bool PERM = false, AFTER_DRAIN = false;
    const float* xp; const float* xs; float* out;
    __device__ __forceinline__ void operator()(const f32x4 (&acc)[2][2][4][2], const Unit& u, int wr, int wc, int fr, int fq) const {
        const int row0 = u.pm * BM + wr * 64 + fr, col0 = u.pn * BM + wc * 32 + 4 * fq;
#pragma unroll
        for (int ai = 0; ai < 2; ++ai)
#pragma unroll
            for (int m = 0; m < 4; ++m) { const int r = row0 + ai * HALF + m * 16;
                const float* xr = (r < MP ? xp + (size_t)r * D_MODEL : xs + (size_t)(r - MP) * D_MODEL) + col0; float* orow = out + O_YP + (size_t)r * D_MODEL + col0;
#pragma unroll
                for (int bj = 0; bj < 2; ++bj)
#pragma unroll
                    for (int n = 0; n < 2; ++n) *(f32x4*)(orow + bj * HALF + n * 16) = *(const f32x4*)(xr + bj * HALF + n * 16) + acc[ai][bj][m][n]; }
    }
};
template <class Epi, class Sched, bool ALIGN_EPI = false, bool SP2 = false>
__device__ __forceinline__ void gemm_phase(PG8_LAS unsigned char* lds, const Gemm g, const Sched& S, const Epi& E) {
    const int tid = threadIdx.x, wid = __builtin_amdgcn_readfirstlane(tid >> 6), lane = tid & 63, wr = wid >> 2, wc = wid & 3, fr = lane & 15, fq = lane >> 4;
    const int K = g.K, nt = K / BK;
    unsigned voffA[2], voffB[2];
#pragma unroll
    for (int i = 0; i < 2; ++i) { int R, C; stage_rc(tid * 16 + i * 8192, R, C); const int Rb = Epi::PERM ? ((R & ~31) + perm32(R & 31)) : R;
        voffA[i] = (unsigned)(R * K + C) * 2u; voffB[i] = (unsigned)(Rb * K + C) * 2u; }
    const size_t kstep = (size_t)(BK * 2);
    const size_t hstep = (size_t)HALF * K * 2;
    const size_t tstep = 2 * hstep;
    const unsigned ldsw = (unsigned)wid * 1024u;
    const int aoff = lds_byte(wr * 64 + fr, fq * 8), boff = lds_byte(wc * 32 + fr, fq * 8);
#define PG8_SA(b, h) (((b) * 2 + (h)) * HTB)
#define PG8_SB(b, h) ((4 + (b) * 2 + (h)) * HTB)
#define PG8_STAGE(bufoff, gbase, voff) do { _Pragma("unroll") for (int _i = 0; _i < 2; ++_i) \
        __builtin_amdgcn_global_load_lds((const unsigned*)((const char*)(gbase) + (voff)[_i]), (PG8_LAS unsigned*)(lds + (bufoff) + ldsw + _i * 8192), 16, 0, 0); } while (0)
#define PG8_LDA(dst, b, h) do { _Pragma("unroll") for (int m = 0; m < 4; ++m) _Pragma("unroll") for (int k = 0; k < 2; ++k) dst[m][k] = *(const PG8_LAS bf16x8*)(lds + PG8_SA(b, h) + aoff + m * 2048 + k * 1024); } while (0)
#define PG8_LDB(dst, b, h) do { _Pragma("unroll") for (int n = 0; n < 2; ++n) _Pragma("unroll") for (int k = 0; k < 2; ++k) dst[n][k] = *(const PG8_LAS bf16x8*)(lds + PG8_SB(b, h) + boff + n * 2048 + k * 1024); } while (0)
#define PG8_MMA(ai, bj, At, Bt) do { __builtin_amdgcn_s_setprio(1); _Pragma("unroll") for (int m = 0; m < 4; ++m) _Pragma("unroll") for (int n = 0; n < 2; ++n) _Pragma("unroll") for (int k = 0; k < 2; ++k) \
        acc[ai][bj][m][n] = __builtin_amdgcn_mfma_f32_16x16x32_bf16(Bt[n][k], At[m][k], acc[ai][bj][m][n], 0, 0, 0); __builtin_amdgcn_s_setprio(0); } while (0)
#define PG8_WAIT_V(n) asm volatile("s_waitcnt vmcnt(" #n ")" ::: "memory")
#define PG8_WAIT_L(n) asm volatile("s_waitcnt lgkmcnt(" #n ")" ::: "memory")
#define PG8_BAR __builtin_amdgcn_s_barrier()
#define PG8_SCHED __builtin_amdgcn_sched_barrier(0)
    Unit cur, nxt; int ui = 0;
    if (!S.next(0, cur)) return;
    f32x4 acc[2][2][4][2];
#pragma unroll
    for (int a = 0; a < 2; ++a)
#pragma unroll
        for (int b = 0; b < 2; ++b)
#pragma unroll
            for (int m = 0; m < 4; ++m)
#pragma unroll
                for (int n = 0; n < 2; ++n) acc[a][b][m][n] = (f32x4){0.f, 0.f, 0.f, 0.f};
    bf16x8 At[4][2], B0[2][2], B1[2][2];
    const char* cA = (const char*)g.A + (size_t)cur.pm * tstep; const char* cB = (const char*)g.Bt + (size_t)cur.pn * tstep;
    S.a_ready(cur);
    if constexpr (SP2) {
        PG8_STAGE(PG8_SB(0, 0), cB, voffB); PG8_STAGE(PG8_SB(0, 1), cB + hstep, voffB); PG8_STAGE(PG8_SA(0, 0), cA, voffA); PG8_STAGE(PG8_SA(0, 1), cA + hstep, voffA);
        if (wr == 1) PG8_BAR;
        PG8_WAIT_V(2); PG8_BAR;
        PG8_STAGE(PG8_SB(1, 0), cB + kstep, voffB); PG8_STAGE(PG8_SA(1, 0), cA + kstep, voffA); PG8_STAGE(PG8_SB(1, 1), cB + hstep + kstep, voffB);
        PG8_WAIT_V(6); PG8_BAR;
    } else {
        PG8_STAGE(PG8_SB(0, 0), cB, voffB); PG8_STAGE(PG8_SA(0, 0), cA, voffA); PG8_STAGE(PG8_SB(0, 1), cB + hstep, voffB); PG8_STAGE(PG8_SA(0, 1), cA + hstep, voffA);
        if (wr == 1) PG8_BAR;
        PG8_WAIT_V(4); PG8_BAR;
        PG8_STAGE(PG8_SB(1, 0), cB + kstep, voffB); PG8_STAGE(PG8_SA(1, 0), cA + kstep, voffA); PG8_STAGE(PG8_SB(1, 1), cB + hstep + kstep, voffB);
        PG8_WAIT_V(6); PG8_BAR;
    }
    for (;;) {
        const bool has_next = S.next(ui + 1, nxt);
        const char* nA = has_next ? (const char*)g.A + (size_t)nxt.pm * tstep : cA; const char* nB = has_next ? (const char*)g.Bt + (size_t)nxt.pn * tstep : cB;
        for (int t = 0; t < nt; t += 2) {
            const bool last = (t == nt - 2);
            const char* a1 = cA + (size_t)(t + 1) * kstep;
            const char* a2 = last ? nA : cA + (size_t)(t + 2) * kstep; const char* b2 = last ? nB : cB + (size_t)(t + 2) * kstep;
            const char* a3 = a2 + kstep; const char* b3 = b2 + kstep;
            if (last && has_next) S.a_ready(nxt);
            if constexpr (SP2) {
            PG8_LDB(B0, 0, 0); PG8_LDB(B1, 0, 1); PG8_SCHED; PG8_LDA(At, 0, 0); PG8_STAGE(PG8_SA(1, 1), a1 + hstep, voffA);
            PG8_WAIT_V(8); PG8_WAIT_L(0); PG8_BAR; PG8_MMA(0, 0, At, B0); PG8_MMA(0, 1, At, B1); PG8_BAR; PG8_SCHED;
            PG8_LDA(At, 0, 1); PG8_STAGE(PG8_SB(0, 0), b2, voffB); PG8_STAGE(PG8_SB(0, 1), b2 + hstep, voffB); PG8_STAGE(PG8_SA(0, 0), a2, voffA);
            PG8_WAIT_V(8); PG8_WAIT_L(0); PG8_BAR; PG8_MMA(1, 0, At, B0); PG8_MMA(1, 1, At, B1); PG8_BAR; PG8_SCHED;
            PG8_LDB(B0, 1, 0); PG8_LDB(B1, 1, 1); PG8_SCHED; PG8_LDA(At, 1, 0); PG8_STAGE(PG8_SA(0, 1), a2 + hstep, voffA);
            PG8_WAIT_V(8); PG8_WAIT_L(0); PG8_BAR; PG8_MMA(0, 0, At, B0); PG8_MMA(0, 1, At, B1); PG8_BAR; PG8_SCHED;
            PG8_LDA(At, 1, 1); PG8_STAGE(PG8_SB(1, 0), b3, voffB); PG8_STAGE(PG8_SB(1, 1), b3 + hstep, voffB); PG8_STAGE(PG8_SA(1, 0), a3, voffA);
            PG8_WAIT_V(8); PG8_WAIT_L(0); PG8_BAR; PG8_MMA(1, 0, At, B0); PG8_MMA(1, 1, At, B1); PG8_BAR; PG8_SCHED;
            } else {
            PG8_LDB(B0, 0, 0); PG8_SCHED; PG8_LDA(At, 0, 0); PG8_STAGE(PG8_SA(1, 1), a1 + hstep, voffA);
            PG8_WAIT_L(8); PG8_BAR; PG8_WAIT_L(0); PG8_MMA(0, 0, At, B0); PG8_BAR; PG8_SCHED;
            PG8_LDB(B1, 0, 1); PG8_STAGE(PG8_SB(0, 0), b2, voffB);
            PG8_BAR; PG8_WAIT_L(0); PG8_MMA(0, 1, At, B1); PG8_BAR;
            PG8_LDA(At, 0, 1); PG8_STAGE(PG8_SA(0, 0), a2, voffA);
            PG8_BAR; PG8_WAIT_L(0); PG8_MMA(1, 0, At, B0); PG8_BAR; PG8_SCHED;
            PG8_STAGE(PG8_SB(0, 1), b2 + hstep, voffB);
            PG8_WAIT_V(6); PG8_BAR; PG8_MMA(1, 1, At, B1); PG8_BAR;
            PG8_LDB(B0, 1, 0); PG8_SCHED; PG8_LDA(At, 1, 0); PG8_STAGE(PG8_SA(0, 1), a2 + hstep, voffA);
            PG8_WAIT_L(8); PG8_BAR; PG8_WAIT_L(0); PG8_MMA(0, 0, At, B0); PG8_BAR; PG8_SCHED;
            PG8_LDB(B1, 1, 1); PG8_STAGE(PG8_SB(1, 0), b3, voffB);
            PG8_BAR; PG8_WAIT_L(0); PG8_MMA(0, 1, At, B1); PG8_BAR;
            PG8_LDA(At, 1, 1); PG8_STAGE(PG8_SA(1, 0), a3, voffA);
            PG8_BAR; PG8_WAIT_L(0); PG8_MMA(1, 0, At, B0); PG8_BAR; PG8_SCHED;
            PG8_STAGE(PG8_SB(1, 1), b3 + hstep, voffB);
            PG8_WAIT_V(6); PG8_BAR; PG8_MMA(1, 1, At, B1); PG8_BAR;
            }
        }
        if constexpr (ALIGN_EPI) { if (wr == 0) PG8_BAR; }
        if constexpr (!Epi::AFTER_DRAIN) { E(acc, cur, wr, wc, fr, fq); S.done(cur); }
        if (!has_next) break;
#pragma unroll
        for (int a = 0; a < 2; ++a)
#pragma unroll
            for (int b = 0; b < 2; ++b)
#pragma unroll
                for (int m = 0; m < 4; ++m)
#pragma unroll
                    for (int n = 0; n < 2; ++n) acc[a][b][m][n] = (f32x4){0.f, 0.f, 0.f, 0.f};
        cur = nxt; cA = nA; cB = nB; ++ui;
        if constexpr (ALIGN_EPI) { if (wr == 1) PG8_BAR; }
    }
    PG8_WAIT_V(0);
    if constexpr (!ALIGN_EPI) { if (wr == 0) PG8_BAR; }
    PG8_BAR;
    if constexpr (Epi::AFTER_DRAIN) { E.fused(acc, cur, wr, wc, fr, fq, lds, wid, lane); S.done(cur); }
#undef PG8_SA
#undef PG8_SB
#undef PG8_STAGE
#undef PG8_LDA
#undef PG8_LDB
#undef PG8_MMA
#undef PG8_WAIT_V
#undef PG8_WAIT_L
#undef PG8_BAR
#undef PG8_SCHED
}
}
constexpr int NWAVES = 8;
constexpr int RING_OFF = 0, RING_BYTES = 131072;
constexpr int LDS_BYTES = 155648;
constexpr int MISC_OFF = LDS_BYTES - 512;
constexpr int PH_LDS = MISC_OFF;
#define GAS __attribute__((address_space(1)))
#define LAS __attribute__((address_space(3)))
typedef unsigned v4u __attribute__((ext_vector_type(4)));
typedef unsigned v2u __attribute__((ext_vector_type(2)));
typedef float f32x4 __attribute__((ext_vector_type(4)));
typedef float f32x2 __attribute__((ext_vector_type(2)));
typedef short bf16x8 __attribute__((ext_vector_type(8)));
typedef short s16x4 __attribute__((ext_vector_type(4)));
typedef GAS unsigned gu32;
typedef GAS unsigned long long gu64;
#define RLX_AGENT __ATOMIC_RELAXED, __HIP_MEMORY_SCOPE_AGENT
#define LDS_WAIT() asm volatile("s_waitcnt lgkmcnt(0)" ::: "memory")
#define VM_WAIT() asm volatile("s_waitcnt vmcnt(0)" ::: "memory")
constexpr int CW_BAR = 4096;
#define XB_TMO      128
#define XB_XCNT(j)  (256  + 64 * (j))
#define XB_XSUB(j)  (1280 + 64 * (j))
#define XB_XGEN(j)  (2304 + 64 * (j))
#define XB_TOP      3328
#define XB_TOPGEN   3392
#define XCD_BAR_WORDS 3456
#define XB_SPIN_CAP (1u << 18)

__device__ __forceinline__ unsigned xb_ld(unsigned* p)              { return __hip_atomic_load(p, __ATOMIC_RELAXED, __HIP_MEMORY_SCOPE_AGENT); }
__device__ __forceinline__ unsigned xb_add(unsigned* p, unsigned v) { return __hip_atomic_fetch_add(p, v, __ATOMIC_RELAXED, __HIP_MEMORY_SCOPE_AGENT); }
__device__ __forceinline__ unsigned xb_xcc_id() { return (unsigned)__builtin_amdgcn_s_getreg((3 << 11) | 20) & 0xFu; }
#define XB_SPIN(cond, bar) do { unsigned _sp = 0; while (cond) { __builtin_amdgcn_s_sleep(1); \
    if ((++_sp & 255u) == 0u) { if (xb_ld(&(bar)[XB_TMO])) break; if (_sp > XB_SPIN_CAP) { atomicAdd(&(bar)[XB_TMO], 1u); break; } } } } while (0)

struct XcdBarrier {
    unsigned* bar; unsigned x;
    volatile LAS unsigned* st;
};

__device__ __forceinline__ XcdBarrier xcd_barrier_post(unsigned* bar, volatile LAS unsigned* st) {
    XcdBarrier b; b.bar = bar; b.x = xb_xcc_id(); b.st = st;
    if (threadIdx.x == 0) (void)xb_add(&bar[XB_XCNT(b.x)], 1u);
    return b;
}
__device__ __forceinline__ void xcd_barrier_complete(unsigned* bar, unsigned x, unsigned& nloc, unsigned& nx) {
    const unsigned G = gridDim.x * gridDim.y * gridDim.z;
    unsigned sum, cnt, mine, sp = 0u;
    for (;;) {
        sum = 0u; cnt = 0u; mine = 0u;
#pragma unroll
        for (unsigned j = 0; j < 16; ++j) { const unsigned c = xb_ld(&bar[XB_XCNT(j)]); sum += c; cnt += (c > 0u) ? 1u : 0u; mine = (j == x) ? c : mine; }
        if (sum == G) break;
        __builtin_amdgcn_s_sleep(1);
        if ((++sp & 255u) == 0u) { if (xb_ld(&bar[XB_TMO])) break; if (sp > XB_SPIN_CAP) { atomicAdd(&bar[XB_TMO], 1u); break; } }
    }
    nloc = mine > 0u ? mine : 1u; nx = cnt > 0u ? cnt : 1u;
}

__device__ __forceinline__ void xcd_barrier(const XcdBarrier& b) {
    asm volatile("s_waitcnt vmcnt(0)" ::: "memory");
    __syncthreads();
    if (threadIdx.x == 0) {
        unsigned* bar = b.bar;
        __builtin_amdgcn_s_waitcnt(0);
        unsigned nloc = b.st[0], nx = b.st[1];
        if (nloc == 0u) { xcd_barrier_complete(bar, b.x, nloc, nx); b.st[0] = nloc; b.st[1] = nx; }
        const unsigned old = xb_add(&bar[XB_XSUB(b.x)], 1u);
        const unsigned gen = old / nloc;
        if (old + 1u == (gen + 1u) * nloc) {
            __builtin_amdgcn_fence(__ATOMIC_RELEASE, "agent");
            asm volatile("s_waitcnt vmcnt(0)" ::: "memory");
            const unsigned og = xb_add(&bar[XB_TOP], 1u);
            const unsigned tg = og / nx;
            if (og + 1u == (tg + 1u) * nx) xb_add(&bar[XB_TOPGEN], 1u);
            else XB_SPIN(xb_ld(&bar[XB_TOPGEN]) == tg, bar);
            __builtin_amdgcn_fence(__ATOMIC_ACQUIRE, "agent");
            xb_add(&bar[XB_XGEN(b.x)], 1u);
            asm volatile("s_waitcnt vmcnt(0)" ::: "memory");
        } else {
            XB_SPIN(xb_ld(&bar[XB_XGEN(b.x)]) == gen, bar);
            __builtin_amdgcn_fence(__ATOMIC_ACQUIRE, "agent");
            asm volatile("s_waitcnt vmcnt(0)" ::: "memory");
        }
    }
    __syncthreads();
}
struct Args { const float* in[17]; float* out; unsigned char* ws; int ph_lo, ph_hi, li, pad; };
struct Frame {
    LAS unsigned char* lds;
    int tid, lane, wave, vcu, G;
};

__device__ __forceinline__ void p0_transpose_item(const float* W, int K, int N, bf16_t* WT, int row_off, LAS float* scr, int item, int lane) {
    const int nblk = N / 32, kb = item / nblk, nb = item % nblk, k0 = 64 * kb, n0 = 32 * nb;
#pragma unroll 8
    for (int i = 0; i < 32; ++i) { const int kk = 2 * i + (lane >> 5); scr[kk * 33 + (lane & 31)] = W[(size_t)(k0 + kk) * N + n0 + (lane & 31)]; }
    LDS_WAIT(); asm volatile("" ::: "memory");
    const int c = lane & 7;
#pragma unroll
    for (int j = 0; j < 4; ++j) { const int n = (lane >> 3) + 8 * j; const LAS float* s = scr + (8 * c) * 33 + n;
        v4u o; o.x = pk2(s[0 * 33], s[1 * 33]); o.y = pk2(s[2 * 33], s[3 * 33]); o.z = pk2(s[4 * 33], s[5 * 33]); o.w = pk2(s[6 * 33], s[7 * 33]);
        *(GAS v4u*)(WT + (size_t)(row_off + n0 + n) * K + k0 + 8 * c) = o; }
    LDS_WAIT(); asm volatile("" ::: "memory");
}
__device__ __forceinline__ void rms_row_to_bf16(const float* xrow, const float* g, bf16_t* orow, int lane) {
    const GAS f32x4* xr = (const GAS f32x4*)xrow + lane; const GAS f32x4* gr = (const GAS f32x4*)g + lane;
    f32x4 v[4]; float s = 0.f;
#pragma unroll
    for (int j = 0; j < 4; ++j) { v[j] = xr[64 * j]; s += (v[j].x * v[j].x + v[j].y * v[j].y) + (v[j].z * v[j].z + v[j].w * v[j].w); }
    const float rs = rsqrtf(wave_sum(s) * (1.f / D_MODEL) + EPS);
    GAS unsigned long long* o8 = (GAS unsigned long long*)orow + lane;
#pragma unroll
    for (int j = 0; j < 4; ++j) { const f32x4 gg = gr[64 * j];
        o8[64 * j] = (unsigned long long)pk2(v[j].x * rs * gg.x, v[j].y * rs * gg.y) | ((unsigned long long)pk2(v[j].z * rs * gg.z, v[j].w * rs * gg.w) << 32); }
}
__device__ __forceinline__ void p0_prologue(const Frame& F, const Args& A) {
    LAS float* scr = (LAS float*)(F.lds + RING_OFF + F.wave * 16384);
    const int gw = F.vcu * NWAVES + F.wave, NGW = F.G * NWAVES;
    bf16_t* WT = (bf16_t*)(A.ws + WS_WT); bf16_t* WOT = (bf16_t*)(A.ws + WS_WOT);
    constexpr int I_IN = (D_MODEL / 64) * (D_IN / 32), I_MEM = (D_MODEL / 64) * (512 / 32), I_OUT = (D_MIX / 64) * (D_MODEL / 32);
    constexpr int NITEMS = I_IN + 2 * I_MEM + I_OUT;
    for (int it = gw; it < NITEMS; it += NGW) {
        int r = it;
        if (r < I_IN) { p0_transpose_item(A.in[8], D_MODEL, D_IN, WT, 0, scr, r, F.lane); continue; } r -= I_IN;
        if (r < I_MEM) { p0_transpose_item(A.in[13], D_MODEL, 512, WT, D_IN, scr, r, F.lane); continue; } r -= I_MEM;
        if (r < I_MEM) { p0_transpose_item(A.in[14], D_MODEL, 512, WT, D_IN + 512, scr, r, F.lane); continue; } r -= I_MEM;
        p0_transpose_item(A.in[15], D_MIX, D_MODEL, WOT, 0, scr, r, F.lane);
    }
    bf16_t* XN = (bf16_t*)((unsigned char*)A.out + OB_XN);
    for (int m = gw; m < M + MMEM; m += NGW) {
        const float* src; const float* g;
        if (m < MP) { src = A.in[0] + (size_t)m * D_MODEL; g = A.in[7]; }
        else if (m < M) { src = A.in[1] + (size_t)(m - MP) * D_MODEL; g = A.in[7]; }
        else { src = A.in[2] + (size_t)(m - M) * D_MODEL; g = A.in[12]; }
        rms_row_to_bf16(src, g, XN + (size_t)m * D_MODEL, F.lane);
    }
    f32x2* rope = (f32x2*)(A.ws + WS_ROPE);
    for (int idx = F.vcu * (NWAVES * 64) + F.tid; idx < SEQ * 32; idx += F.G * NWAVES * 64) {
        const int pos = idx >> 5, i = idx & 31;
        const float inv = expf(-(float)i * (1.f / 32.f) * 9.210340371976184f);
        float sn, cs; sincosf((float)pos * inv, &sn, &cs);
        rope[idx] = (f32x2){cs, sn};
    }
}

#define MFMA16(a, b, c) __builtin_amdgcn_mfma_f32_16x16x32_bf16((a), (b), (c), 0, 0, 0)
__device__ __forceinline__ bf16x8 ldfrag(const LAS bf16_t* base, int pitch, int row, int k) { return *(const LAS bf16x8*)(base + row * pitch + k); }
__device__ __forceinline__ unsigned cvtpk(float lo, float hi) { unsigned r; asm volatile("v_cvt_pk_bf16_f32 %0, %1, %2" : "=v"(r) : "v"(lo), "v"(hi)); return r; }

constexpr int XA_KP = 136, XA_VP = 264;
constexpr int XA_UNITS_P = BATCH * XA_H * (SEQ / 256), XA_UNITS = XA_UNITS_P + DEC_BATCH * XA_H;
__device__ __forceinline__ void xattn_unit(const Frame& F, const Args& A, int unit) {
    LAS bf16_t* Ks = (LAS bf16_t*)(F.lds); LAS bf16_t* VTs = (LAS bf16_t*)(F.lds + 256 * XA_KP * 2);
    int h, row0, ntile; const float *Kb, *Vb;
    if (unit < XA_UNITS_P) { const int rb = unit & 31, bh = unit >> 5, b = bh >> 2; h = bh & 3; row0 = b * SEQ + rb * 256; ntile = 16;
        Kb = A.out + O_MKP + (size_t)b * N_MEM * 512; Vb = A.out + O_MVP + (size_t)b * N_MEM * 512; }
    else { const int u2 = unit - XA_UNITS_P, b = u2 >> 2; h = u2 & 3; row0 = MP + b * DEC_SEQ; ntile = 4;
        Kb = A.in[5] + (size_t)b * N_MEM * 512; Vb = A.in[6] + (size_t)b * N_MEM * 512; }
    const int tid = F.tid, lane = F.lane, w = F.wave, fr = lane & 15, g = lane >> 4;
#pragma unroll 4
    for (int it = 0; it < 16; ++it) { const int idx = it * 512 + tid, m = idx >> 5, c4 = idx & 31;
        const f32x4 v = *(const GAS f32x4*)(Kb + (size_t)m * 512 + h * 128 + 4 * c4);
        *(LAS v2u*)(Ks + m * XA_KP + 4 * c4) = (v2u){pk2(v.x, v.y), pk2(v.z, v.w)}; }
#pragma unroll 2
    for (int it = 0; it < 8; ++it) { const int idx = it * 512 + tid, c4 = idx & 31, mp = idx >> 5;
        const f32x4 v0 = *(const GAS f32x4*)(Vb + (size_t)(2 * mp) * 512 + h * 128 + 4 * c4), v1 = *(const GAS f32x4*)(Vb + (size_t)(2 * mp + 1) * 512 + h * 128 + 4 * c4);
        LAS unsigned* d = (LAS unsigned*)(VTs + (4 * c4) * XA_VP + 2 * mp);
        d[0] = pk2(v0.x, v1.x); d[XA_VP / 2] = pk2(v0.y, v1.y); d[XA_VP] = pk2(v0.z, v1.z); d[3 * (XA_VP / 2)] = pk2(v0.w, v1.w); }
    __syncthreads();
    const bf16_t* XQ = (const bf16_t*)(A.ws + WS_XQ); bf16_t* MIX = (bf16_t*)(A.ws + WS_MIX);
    for (int t = w; t < ntile; t += NWAVES) {
        const int r0 = row0 + 16 * t;
        bf16x8 qf[4];
#pragma unroll
        for (int ks = 0; ks < 4; ++ks) qf[ks] = *(const GAS bf16x8*)(XQ + (size_t)(r0 + fr) * 512 + h * 128 + 32 * ks + 8 * g);
        f32x4 s[16];
#pragma unroll
        for (int nt = 0; nt < 16; ++nt) { f32x4 acc = {0.f, 0.f, 0.f, 0.f};
#pragma unroll
            for (int ks = 0; ks < 4; ++ks) acc = MFMA16(ldfrag(Ks, XA_KP, 16 * nt + fr, 32 * ks + 8 * g), qf[ks], acc);
            s[nt] = acc; }
        float mx = -3.0e38f;
#pragma unroll
        for (int nt = 0; nt < 16; ++nt) mx = fmaxf(fmaxf(mx, fmaxf(s[nt][0], s[nt][1])), fmaxf(s[nt][2], s[nt][3]));
        mx = fmaxf(mx, __shfl_xor(mx, 16)); mx = fmaxf(mx, __shfl_xor(mx, 32));
        const float c = 0.08838834764831845f * 1.4426950408889634f, mc = mx * c;
        float sm = 0.f;
#pragma unroll
        for (int nt = 0; nt < 16; ++nt)
#pragma unroll
            for (int r = 0; r < 4; ++r) { const float p = exp2f(s[nt][r] * c - mc); s[nt][r] = p; sm += p; }
        sm += __shfl_xor(sm, 16); sm += __shfl_xor(sm, 32);
        const float inv = 1.f / sm;
        f32x4 o[8];
#pragma unroll
        for (int et = 0; et < 8; ++et) o[et] = (f32x4){0.f, 0.f, 0.f, 0.f};
#pragma unroll
        for (int s2 = 0; s2 < 8; ++s2) {
            union { bf16x8 v; unsigned u[4]; } pb;
            pb.u[0] = cvtpk(s[2 * s2][0], s[2 * s2][1]); pb.u[1] = cvtpk(s[2 * s2][2], s[2 * s2][3]);
            pb.u[2] = cvtpk(s[2 * s2 + 1][0], s[2 * s2 + 1][1]); pb.u[3] = cvtpk(s[2 * s2 + 1][2], s[2 * s2 + 1][3]);
#pragma unroll
            for (int et = 0; et < 8; ++et) {
                union { bf16x8 v; v2u h2[2]; } va;
                const LAS bf16_t* vp = VTs + (16 * et + fr) * XA_VP + 32 * s2 + 4 * g;
                va.h2[0] = *(const LAS v2u*)vp; va.h2[1] = *(const LAS v2u*)(vp + 16);
                o[et] = MFMA16(va.v, pb.v, o[et]);
            }
        }
#pragma unroll
        for (int et = 0; et < 8; ++et) {
            bf16_t* mp = MIX + (size_t)(r0 + fr) * 2048 + 1536 + h * 128 + 16 * et + 4 * g;
            const v2u gt = *(const GAS v2u*)mp;
            v2u ov; ov.x = pk2(o[et][0] * inv * bflo(gt.x), o[et][1] * inv * bfhi(gt.x)); ov.y = pk2(o[et][2] * inv * bflo(gt.y), o[et][3] * inv * bfhi(gt.y));
            *(GAS v2u*)mp = ov;
        }
    }
    __syncthreads();
}

constexpr int HP = 136, TP = 72;
constexpr int HG_QS = 0, HG_KS = HG_QS + 64 * HP * 2, HG_KT = HG_KS + 64 * HP * 2, HG_VT = HG_KT + 128 * TP * 2, HG_PS = HG_VT + 128 * TP * 2, HG_ST = HG_PS + 64 * TP * 2,
              HG_SEG = HG_ST + 128 * HP * 2, HG_E1 = HG_SEG + 4 * 128 * 4, HG_E2 = HG_E1 + 512, HG_RED = HG_E2 + 512, HG_END = HG_RED + 8 * 64 * 4;
static_assert(HG_END <= PH_LDS, "hgrn LDS");
template <bool FULL>
__device__ __forceinline__ void hgrn_seq(const Frame& F, const Args& A, int h, int row0, int nchunk, const float* s_in, float* s_out, float* gd_out) {
    LAS bf16_t* Qs = (LAS bf16_t*)(F.lds + HG_QS); LAS bf16_t* Ks = (LAS bf16_t*)(F.lds + HG_KS); LAS bf16_t* KTs = (LAS bf16_t*)(F.lds + HG_KT);
    LAS bf16_t* VTs = (LAS bf16_t*)(F.lds + HG_VT); LAS bf16_t* Ps = (LAS bf16_t*)(F.lds + HG_PS); LAS bf16_t* STs = (LAS bf16_t*)(F.lds + HG_ST);
    LAS float* segtot = (LAS float*)(F.lds + HG_SEG); LAS float* E1 = (LAS float*)(F.lds + HG_E1); LAS float* E2 = (LAS float*)(F.lds + HG_E2); LAS float* red = (LAS float*)(F.lds + HG_RED);
    const int tid = F.tid, lane = F.lane, w = F.wave, fr = lane & 15, g = lane >> 4;
    const int d = tid & 127, seg = tid >> 7;
    const bf16_t *HQ = (const bf16_t*)(A.ws + WS_HQ), *HF = (const bf16_t*)(A.ws + WS_HF), *HI = (const bf16_t*)(A.ws + WS_HI); bf16_t* MIX = (bf16_t*)(A.ws + WS_MIX);
    const float lbv = 1.f / (1.f + __expf(A.in[9][1024 + h * 128 + d] - A.in[9][h * 128 + d]));
    f32x4 S[8];
#pragma unroll
    for (int dt = 0; dt < 8; ++dt) {
        if (s_in) { const float* sp = s_in + (size_t)(16 * dt + 4 * g) * 128 + 16 * w + fr; S[dt] = (f32x4){sp[0], sp[128], sp[256], sp[384]}; }
        else S[dt] = (f32x4){0.f, 0.f, 0.f, 0.f};
    }
    float gdsum = 0.f;
    const int v_eg = (lane & 3) + 4 * (w >> 1), v_jp = (lane >> 2) + 16 * (w & 1);
    for (int c = 0; c < nchunk; ++c) {
        const int r0 = row0 + c * CHUNK;
        float fx[16], qx[16];
        { const bf16_t* fp = HF + (size_t)(r0 + 16 * seg) * 1024 + h * 128 + d; const bf16_t* qp = HQ + (size_t)(r0 + 16 * seg) * 1024 + h * 128 + d;
#pragma unroll
          for (int t = 0; t < 16; ++t) { fx[t] = bf2f(fp[(size_t)t * 1024]); if (FULL) qx[t] = bf2f(qp[(size_t)t * 1024]); } }
        const v4u va = *(const GAS v4u*)(HI + (size_t)(r0 + 2 * v_jp) * 1024 + h * 128 + 8 * v_eg), vb = *(const GAS v4u*)(HI + (size_t)(r0 + 2 * v_jp + 1) * 1024 + h * 128 + 8 * v_eg);
        float kx[16], gc[16]; float run = 0.f;
#pragma unroll
        for (int t = 0; t < 16; ++t) { const float x = fminf(fmaxf(fx[t], -60.f), 60.f), e_ = __expf(-x), sig = __builtin_amdgcn_rcpf(1.f + e_);
            const float f = lbv + (1.f - lbv) * sig; kx[t] = (1.f - lbv) * e_ * sig; run += __logf(f); gc[t] = run; }
        segtot[seg * 128 + d] = run;
        { LAS unsigned* vd = (LAS unsigned*)(VTs + (8 * v_eg) * TP + 2 * v_jp);
          vd[0] = (va.x & 0xffffu) | (vb.x << 16); vd[TP / 2] = (va.x >> 16) | (vb.x & 0xffff0000u); vd[TP] = (va.y & 0xffffu) | (vb.y << 16); vd[3 * (TP / 2)] = (va.y >> 16) | (vb.y & 0xffff0000u);
          vd[2 * TP] = (va.z & 0xffffu) | (vb.z << 16); vd[5 * (TP / 2)] = (va.z >> 16) | (vb.z & 0xffff0000u); vd[3 * TP] = (va.w & 0xffffu) | (vb.w << 16); vd[7 * (TP / 2)] = (va.w >> 16) | (vb.w & 0xffff0000u); }
        __syncthreads();
        const float t0 = segtot[d], t1 = segtot[128 + d], t2 = segtot[256 + d], t3 = segtot[384 + d];
        const float gref = t0 + t1, gtot = gref + (t2 + t3);
        const float base = (seg == 0 ? 0.f : seg == 1 ? t0 : seg == 2 ? gref : gref + t2) - gref;
        if (seg == 0) { E1[d] = __expf(gref); E2[d] = __expf(gtot - gref); gdsum += gtot; }
        {
            union { v4u v[2]; unsigned short s[16]; } kt;
#pragma unroll
            for (int t = 0; t < 16; ++t) { const float rel = base + gc[t];
                const unsigned short kb = (unsigned short)f2bf(kx[t] * __expf(-rel)); kt.s[t] = kb;
                if (FULL) { Ks[(16 * seg + t) * HP + d] = kb; Qs[(16 * seg + t) * HP + d] = (unsigned short)f2bf(qx[t] * __expf(rel)); } }
            *(LAS v4u*)(KTs + d * TP + 16 * seg) = kt.v[0]; *(LAS v4u*)(KTs + d * TP + 16 * seg + 8) = kt.v[1];
        }
        __syncthreads();
#pragma unroll
        for (int dt = 0; dt < 8; ++dt) { const f32x4 e1 = *(const LAS f32x4*)(E1 + 16 * dt + 4 * g); S[dt] = S[dt] * e1;
            if (FULL) *(LAS v2u*)(STs + (16 * w + fr) * HP + 16 * dt + 4 * g) = (v2u){cvtpk(S[dt][0], S[dt][1]), cvtpk(S[dt][2], S[dt][3])}; }
        if (FULL) {
            const int jt = w & 3;
#pragma unroll
            for (int i2 = 0; i2 < 2; ++i2) { const int it = 2 * (w >> 2) + i2; f32x4 acc = {0.f, 0.f, 0.f, 0.f};
#pragma unroll
                for (int ks = 0; ks < 4; ++ks) acc = MFMA16(ldfrag(Ks, HP, 16 * jt + fr, 32 * ks + 8 * g), ldfrag(Qs, HP, 16 * it + fr, 32 * ks + 8 * g), acc);
                const int i = 16 * it + fr, j0 = 16 * jt + 4 * g;
                *(LAS v2u*)(Ps + i * TP + j0) = (v2u){cvtpk(j0 <= i ? acc[0] : 0.f, j0 + 1 <= i ? acc[1] : 0.f), cvtpk(j0 + 2 <= i ? acc[2] : 0.f, j0 + 3 <= i ? acc[3] : 0.f)}; }
            __syncthreads();
        }
        bf16x8 vt[2];
#pragma unroll
        for (int ks = 0; ks < 2; ++ks) vt[ks] = ldfrag(VTs, TP, 16 * w + fr, 32 * ks + 8 * g);
        f32x4 o[4];
        if (FULL) {
            bf16x8 st[4];
#pragma unroll
            for (int ks = 0; ks < 4; ++ks) st[ks] = ldfrag(STs, HP, 16 * w + fr, 32 * ks + 8 * g);
#pragma unroll
            for (int it = 0; it < 4; ++it) { f32x4 acc = {0.f, 0.f, 0.f, 0.f};
#pragma unroll
                for (int ks = 0; ks < 2; ++ks) acc = MFMA16(vt[ks], ldfrag(Ps, TP, 16 * it + fr, 32 * ks + 8 * g), acc);
#pragma unroll
                for (int ks = 0; ks < 4; ++ks) acc = MFMA16(st[ks], ldfrag(Qs, HP, 16 * it + fr, 32 * ks + 8 * g), acc);
                o[it] = acc; }
        }
#pragma unroll
        for (int dt = 0; dt < 8; ++dt) {
#pragma unroll
            for (int ks = 0; ks < 2; ++ks) S[dt] = MFMA16(ldfrag(KTs, TP, 16 * dt + fr, 32 * ks + 8 * g), vt[ks], S[dt]);
            const f32x4 e2 = *(const LAS f32x4*)(E2 + 16 * dt + 4 * g); S[dt] = S[dt] * e2; }
        if (FULL) {
#pragma unroll
            for (int it = 0; it < 4; ++it) { float q = (o[it][0] * o[it][0] + o[it][1] * o[it][1]) + (o[it][2] * o[it][2] + o[it][3] * o[it][3]);
                q += __shfl_xor(q, 16); q += __shfl_xor(q, 32);
                if (g == 0) red[w * 64 + 16 * it + fr] = q; }
            __syncthreads();
            const f32x4 gn = *(const GAS f32x4*)(A.in[10] + h * 128 + 16 * w + 4 * g);
#pragma unroll
            for (int it = 0; it < 4; ++it) { const int i = 16 * it + fr; float q = 0.f;
#pragma unroll
                for (int ww = 0; ww < 8; ++ww) q += red[ww * 64 + i];
                const float rs = rsqrtf(q * (1.f / 128.f) + EPS);
                bf16_t* mp = MIX + (size_t)(r0 + i) * 2048 + h * 128 + 16 * w + 4 * g;
                const v2u gt = *(const GAS v2u*)mp;
                v2u ov; ov.x = pk2(o[it][0] * rs * gn.x * bflo(gt.x), o[it][1] * rs * gn.y * bfhi(gt.x)); ov.y = pk2(o[it][2] * rs * gn.z * bflo(gt.y), o[it][3] * rs * gn.w * bfhi(gt.y));
                *(GAS v2u*)mp = ov; }
        } else {
            __syncthreads();
        }
    }
    if (s_out) {
#pragma unroll
        for (int dt = 0; dt < 8; ++dt) { float* sp = s_out + (size_t)(16 * dt + 4 * g) * 128 + 16 * w + fr; sp[0] = S[dt][0]; sp[128] = S[dt][1]; sp[256] = S[dt][2]; sp[384] = S[dt][3]; }
    }
    if (gd_out && seg == 0) gd_out[d] = gdsum;
    __syncthreads();
}

constexpr int RT_RQ = 0, RT_RK = RT_RQ + 64 * TP * 2, RT_KT = RT_RK + 64 * TP * 2, RT_VT = RT_KT + 64 * TP * 2, RT_PS = RT_VT + 128 * TP * 2, RT_RT = RT_PS + 64 * TP * 2,
              RT_GP = RT_RT + 128 * TP * 2, RT_RED = RT_GP + 320, RT_END = RT_RED + 8 * 64 * 2 * 4;
static_assert(RT_END <= PH_LDS, "retention LDS");
template <bool FULL>
__device__ __forceinline__ void ret_seq(const Frame& F, const Args& A, int h, int row0, int pos0, int nchunk, const float* s_in, float* s_out) {
    LAS bf16_t* RQs = (LAS bf16_t*)(F.lds + RT_RQ); LAS bf16_t* RKs = (LAS bf16_t*)(F.lds + RT_RK); LAS bf16_t* RKT = (LAS bf16_t*)(F.lds + RT_KT);
    LAS bf16_t* RVT = (LAS bf16_t*)(F.lds + RT_VT); LAS bf16_t* Ps = (LAS bf16_t*)(F.lds + RT_PS); LAS bf16_t* RTs = (LAS bf16_t*)(F.lds + RT_RT);
    LAS float* gpow = (LAS float*)(F.lds + RT_GP); LAS float* red = (LAS float*)(F.lds + RT_RED);
    const int tid = F.tid, lane = F.lane, w = F.wave, fr = lane & 15, g = lane >> 4;
    const bf16_t *RQ = (const bf16_t*)(A.ws + WS_RQ), *RK = (const bf16_t*)(A.ws + WS_RK), *RV = (const bf16_t*)(A.ws + WS_RV); bf16_t* MIX = (bf16_t*)(A.ws + WS_MIX);
    const f32x2* rope = (const f32x2*)(A.ws + WS_ROPE);
    const float lg = log1pf(-exp2f(-5.f - (float)h));
    if (tid < 65) gpow[tid] = expf(lg * (float)tid);
    f32x4 R[4];
#pragma unroll
    for (int dt = 0; dt < 4; ++dt) {
        if (s_in) { const float* sp = s_in + (size_t)(16 * dt + 4 * g) * 128 + 16 * w + fr; R[dt] = (f32x4){sp[0], sp[128], sp[256], sp[384]}; }
        else R[dt] = (f32x4){0.f, 0.f, 0.f, 0.f};
    }
    const int e_t = tid >> 3, e_i = 4 * (tid & 7);
    const int v_eg = (lane & 3) + 4 * (w >> 1), v_jp = (lane >> 2) + 16 * (w & 1);
    __syncthreads();
    const float cd = gpow[64];
    for (int c = 0; c < nchunk; ++c) {
        const int r0 = row0 + c * CHUNK;
        {
            const size_t rb = (size_t)(r0 + e_t) * 256 + h * 64 + e_i;
            const v2u k1 = *(const GAS v2u*)(RK + rb), k2 = *(const GAS v2u*)(RK + rb + 32);
            v2u q1, q2; if (FULL) { q1 = *(const GAS v2u*)(RQ + rb); q2 = *(const GAS v2u*)(RQ + rb + 32); }
            const f32x4* rp = (const f32x4*)(rope + (size_t)(pos0 + c * CHUNK + e_t) * 32 + e_i);
            const f32x4 cs01 = rp[0], cs23 = rp[1];
            const float cs[4] = {cs01.x, cs01.z, cs23.x, cs23.z}, sn[4] = {cs01.y, cs01.w, cs23.y, cs23.w};
            const float ka[4] = {bflo(k1.x), bfhi(k1.x), bflo(k1.y), bfhi(k1.y)}, kb[4] = {bflo(k2.x), bfhi(k2.x), bflo(k2.y), bfhi(k2.y)};
            float o1[4], o2[4];
#pragma unroll
            for (int i = 0; i < 4; ++i) { o1[i] = (ka[i] * cs[i] - kb[i] * sn[i]) * 0.125f; o2[i] = (ka[i] * sn[i] + kb[i] * cs[i]) * 0.125f; }
            if (FULL) { *(LAS v2u*)(RKs + e_t * TP + e_i) = (v2u){pk2(o1[0], o1[1]), pk2(o1[2], o1[3])}; *(LAS v2u*)(RKs + e_t * TP + 32 + e_i) = (v2u){pk2(o2[0], o2[1]), pk2(o2[2], o2[3])}; }
            const float kd = gpow[63 - e_t];
#pragma unroll
            for (int i = 0; i < 4; ++i) { RKT[(e_i + i) * TP + e_t] = (unsigned short)f2bf(o1[i] * kd); RKT[(32 + e_i + i) * TP + e_t] = (unsigned short)f2bf(o2[i] * kd); }
            if (FULL) {
                const float qa[4] = {bflo(q1.x), bfhi(q1.x), bflo(q1.y), bfhi(q1.y)}, qb[4] = {bflo(q2.x), bfhi(q2.x), bflo(q2.y), bfhi(q2.y)};
#pragma unroll
                for (int i = 0; i < 4; ++i) { o1[i] = qa[i] * cs[i] - qb[i] * sn[i]; o2[i] = qa[i] * sn[i] + qb[i] * cs[i]; }
                *(LAS v2u*)(RQs + e_t * TP + e_i) = (v2u){pk2(o1[0], o1[1]), pk2(o1[2], o1[3])}; *(LAS v2u*)(RQs + e_t * TP + 32 + e_i) = (v2u){pk2(o2[0], o2[1]), pk2(o2[2], o2[3])};
            }
        }
        {
            const v4u va = *(const GAS v4u*)(RV + (size_t)(r0 + 2 * v_jp) * 512 + h * 128 + 8 * v_eg), vb = *(const GAS v4u*)(RV + (size_t)(r0 + 2 * v_jp + 1) * 512 + h * 128 + 8 * v_eg);
            LAS unsigned* vd = (LAS unsigned*)(RVT + (8 * v_eg) * TP + 2 * v_jp);
            vd[0] = (va.x & 0xffffu) | (vb.x << 16); vd[TP / 2] = (va.x >> 16) | (vb.x & 0xffff0000u); vd[TP] = (va.y & 0xffffu) | (vb.y << 16); vd[3 * (TP / 2)] = (va.y >> 16) | (vb.y & 0xffff0000u);
            vd[2 * TP] = (va.z & 0xffffu) | (vb.z << 16); vd[5 * (TP / 2)] = (va.z >> 16) | (vb.z & 0xffff0000u); vd[3 * TP] = (va.w & 0xffffu) | (vb.w << 16); vd[7 * (TP / 2)] = (va.w >> 16) | (vb.w & 0xffff0000u);
        }
        if (FULL) {
#pragma unroll
            for (int dt = 0; dt < 4; ++dt) *(LAS v2u*)(RTs + (16 * w + fr) * TP + 16 * dt + 4 * g) = (v2u){cvtpk(R[dt][0], R[dt][1]), cvtpk(R[dt][2], R[dt][3])};
        }
        __syncthreads();
        if (FULL) {
            const int jt = w & 3;
#pragma unroll
            for (int i2 = 0; i2 < 2; ++i2) { const int it = 2 * (w >> 2) + i2; f32x4 acc = {0.f, 0.f, 0.f, 0.f};
#pragma unroll
                for (int ks = 0; ks < 2; ++ks) acc = MFMA16(ldfrag(RKs, TP, 16 * jt + fr, 32 * ks + 8 * g), ldfrag(RQs, TP, 16 * it + fr, 32 * ks + 8 * g), acc);
                const int i = 16 * it + fr, j0 = 16 * jt + 4 * g;
                float pw[4];
#pragma unroll
                for (int r = 0; r < 4; ++r) { const int dd = i - (j0 + r); pw[r] = acc[r] * gpow[dd < 0 ? -dd : dd]; }
                *(LAS v2u*)(Ps + i * TP + j0) = (v2u){cvtpk(pw[0], pw[1]), cvtpk(pw[2], pw[3])}; }
            __syncthreads();
        }
        bf16x8 vt[2];
#pragma unroll
        for (int ks = 0; ks < 2; ++ks) vt[ks] = ldfrag(RVT, TP, 16 * w + fr, 32 * ks + 8 * g);
        f32x4 o[4];
        if (FULL) {
            bf16x8 rt[2];
#pragma unroll
            for (int ks = 0; ks < 2; ++ks) rt[ks] = ldfrag(RTs, TP, 16 * w + fr, 32 * ks + 8 * g);
#pragma unroll
            for (int it = 0; it < 4; ++it) { f32x4 a1 = {0.f, 0.f, 0.f, 0.f}, a2 = {0.f, 0.f, 0.f, 0.f};
#pragma unroll
                for (int ks = 0; ks < 2; ++ks) { a1 = MFMA16(vt[ks], ldfrag(Ps, TP, 16 * it + fr, 32 * ks + 8 * g), a1); a2 = MFMA16(rt[ks], ldfrag(RQs, TP, 16 * it + fr, 32 * ks + 8 * g), a2); }
                o[it] = a1 + a2 * gpow[16 * it + fr + 1]; }
        }
#pragma unroll
        for (int dt = 0; dt < 4; ++dt) { R[dt] = R[dt] * cd;
#pragma unroll
            for (int ks = 0; ks < 2; ++ks) R[dt] = MFMA16(ldfrag(RKT, TP, 16 * dt + fr, 32 * ks + 8 * g), vt[ks], R[dt]); }
        if (FULL) {
#pragma unroll
            for (int it = 0; it < 4; ++it) { float s1 = (o[it][0] + o[it][1]) + (o[it][2] + o[it][3]), s2 = (o[it][0] * o[it][0] + o[it][1] * o[it][1]) + (o[it][2] * o[it][2] + o[it][3] * o[it][3]);
                s1 += __shfl_xor(s1, 16); s1 += __shfl_xor(s1, 32); s2 += __shfl_xor(s2, 16); s2 += __shfl_xor(s2, 32);
                if (g == 0) *(LAS f32x2*)(red + (w * 64 + 16 * it + fr) * 2) = (f32x2){s1, s2}; }
            __syncthreads();
            const f32x4 gn = *(const GAS f32x4*)(A.in[11] + h * 128 + 16 * w + 4 * g);
#pragma unroll
            for (int it = 0; it < 4; ++it) { const int i = 16 * it + fr; float s1 = 0.f, s2 = 0.f;
#pragma unroll
                for (int ww = 0; ww < 8; ++ww) { const f32x2 p = *(const LAS f32x2*)(red + (ww * 64 + i) * 2); s1 += p.x; s2 += p.y; }
                const float mu = s1 * (1.f / 128.f), var = fmaxf(s2 * (1.f / 128.f) - mu * mu, 0.f), rs = rsqrtf(var + EPS);
                bf16_t* mp = MIX + (size_t)(r0 + i) * 2048 + 1024 + h * 128 + 16 * w + 4 * g;
                const v2u gt = *(const GAS v2u*)mp;
                v2u ov; ov.x = pk2((o[it][0] - mu) * rs * gn.x * bflo(gt.x), (o[it][1] - mu) * rs * gn.y * bfhi(gt.x)); ov.y = pk2((o[it][2] - mu) * rs * gn.z * bflo(gt.y), (o[it][3] - mu) * rs * gn.w * bfhi(gt.y));
                *(GAS v2u*)mp = ov; }
        } else {
            __syncthreads();
        }
    }
    if (s_out) {
#pragma unroll
        for (int dt = 0; dt < 4; ++dt) { float* sp = s_out + (size_t)(16 * dt + 4 * g) * 128 + 16 * w + fr; sp[0] = R[dt][0]; sp[128] = R[dt][1]; sp[256] = R[dt][2]; sp[384] = R[dt][3]; }
    }
    __syncthreads();
}

#ifndef MK_GRID_BAR
#define MK_GRID_BAR 1
#endif
__global__ void __launch_bounds__(NWAVES * 64, 2) mk_fwd(Args args) {
    extern __shared__ __attribute__((aligned(16))) unsigned char lds[];
    Frame F;
    F.lds = (LAS unsigned char*)lds;
    F.tid = threadIdx.x; F.lane = F.tid & 63; F.wave = __builtin_amdgcn_readfirstlane(F.tid >> 6);
    F.G = gridDim.x; { const int bx = blockIdx.x; F.vcu = (F.G % 8 == 0) ? (bx % 8) * (F.G / 8) + bx / 8 : bx; }
    volatile LAS unsigned* MISC = (volatile LAS unsigned*)(F.lds + MISC_OFF);
    for (int u = F.tid; u < (LDS_BYTES - MISC_OFF) / 4; u += NWAVES * 64) ((LAS unsigned*)(F.lds + MISC_OFF))[u] = 0u;
    __syncthreads();
    const int lo = args.ph_lo, hi = args.ph_hi;
    unsigned* barw = (unsigned*)(args.ws + WS_CTL) + CW_BAR + args.li * XCD_BAR_WORDS;
    XcdBarrier bar; bar.bar = barw; bar.x = 0; bar.st = nullptr;
    if (hi - lo > 1) bar = xcd_barrier_post(barw, MISC + 8);
#define IN(k) (lo <= (k) && (k) < hi)
#define BOTH(k) (IN(k) && IN((k) + 1))
#define GRID_BAR() xcd_barrier(bar)

    if (IN(0)) { p0_prologue(F, args); if (BOTH(0)) GRID_BAR(); }
    if (IN(1)) {
        pg8::Gemm g{(const bf16_t*)((unsigned char*)args.out + OB_XN), (const bf16_t*)(args.ws + WS_WT), M + MMEM, D_IN + 1024, D_MODEL};
        pg8::ProjOrder S; S.init(F.G, (int)blockIdx.x);
        pg8::EpiProj E{args.ws, args.out};
        pg8::gemm_phase<pg8::EpiProj, pg8::ProjOrder, true, true>(F.lds + RING_OFF, g, S, E);
        if (BOTH(1)) GRID_BAR();
    }
        if (IN(2)) {
        float* GSH = (float*)((unsigned char*)args.out + OB_GSH); float* GSR = (float*)((unsigned char*)args.out + OB_GSR); float* GDH = (float*)((unsigned char*)args.out + OB_GDH);
        constexpr int NH1 = BATCH * NG * HG_H, NR1 = BATCH * NG * RT_H;
        for (int u = (int)blockIdx.x; u < XA_UNITS + NH1 + NR1; u += F.G) {
            Frame F2 = F; { int t_ = threadIdx.x; asm volatile("" : "+v"(t_)); F2.tid = t_; F2.lane = t_ & 63; F2.wave = __builtin_amdgcn_readfirstlane(t_ >> 6); }
            if (u < XA_UNITS) xattn_unit(F2, args, u);
            else if (u < XA_UNITS + NH1) { const int v = u - XA_UNITS, h = v & 7, bg = v >> 3, b = bg / NG, g = bg % NG;
                hgrn_seq<false>(F2, args, h, b * SEQ + g * NCG * CHUNK, NCG, nullptr, GSH + (size_t)v * 16384, GDH + (size_t)v * 128); }
            else { const int v = u - XA_UNITS - NH1, h = v & 3, bg = v >> 2, b = bg / NG, g = bg % NG;
                ret_seq<false>(F2, args, h, b * SEQ + g * NCG * CHUNK, g * NCG * CHUNK, NCG, nullptr, GSR + (size_t)v * 8192); }
        }
        if (BOTH(2)) GRID_BAR();
    }
    if (IN(3)) {
        float* GSH = (float*)((unsigned char*)args.out + OB_GSH); float* GSR = (float*)((unsigned char*)args.out + OB_GSR); const float* GDH = (const float*)((unsigned char*)args.out + OB_GDH);
        const int gt = F.vcu * (NWAVES * 64) + F.tid, NT = F.G * NWAVES * 64;
        for (int idx = gt; idx < BATCH * HG_H * 16384; idx += NT) {
            const int b = idx >> 17, h = (idx >> 14) & 7, de = idx & 16383, d = de >> 7; float s = 0.f;
#pragma unroll 8
            for (int g = 0; g < NG; ++g) { const size_t v = (size_t)((b * NG + g) * HG_H + h); float* p = GSH + v * 16384 + de; const float tmp = *p; *p = s; s = __expf(GDH[v * 128 + d]) * s + tmp; }
            args.out[O_HGP + (size_t)(b * HG_H + h) * 16384 + de] = s;
        }
        for (int idx = gt; idx < BATCH * RT_H * 8192; idx += NT) {
            const int b = idx >> 15, h = (idx >> 13) & 3, de = idx & 8191; float s = 0.f;
            const float dec = expf(log1pf(-exp2f(-5.f - (float)h)) * (float)(CHUNK * NCG));
#pragma unroll 8
            for (int g = 0; g < NG; ++g) { float* p = GSR + (size_t)((b * NG + g) * RT_H + h) * 8192 + de; const float tmp = *p; *p = s; s = dec * s + tmp; }
            args.out[O_RTP + (size_t)(b * RT_H + h) * 8192 + de] = s;
        }
        if (BOTH(3)) GRID_BAR();
    }
    if (IN(4)) {
        const float* GSH = (const float*)((unsigned char*)args.out + OB_GSH); const float* GSR = (const float*)((unsigned char*)args.out + OB_GSR);
        constexpr int NH1 = BATCH * NG * HG_H, NR1 = BATCH * NG * RT_H, NHS = DEC_BATCH * HG_H, NRS = DEC_BATCH * RT_H;
        for (int u = (int)blockIdx.x; u < NH1 + NR1 + NHS + NRS; u += F.G) {
            Frame F2 = F; { int t_ = threadIdx.x; asm volatile("" : "+v"(t_)); F2.tid = t_; F2.lane = t_ & 63; F2.wave = __builtin_amdgcn_readfirstlane(t_ >> 6); }
            int h, row0, pos0, nch; const float* s_in; float* s_out; bool is_h;
            if (u < NH1) { const int v = u, bg = v >> 3, b = bg / NG, g = bg % NG; h = v & 7; is_h = true;
                row0 = b * SEQ + g * NCG * CHUNK; pos0 = 0; nch = NCG; s_in = GSH + (size_t)v * 16384; s_out = nullptr; }
            else if (u < NH1 + NR1) { const int v = u - NH1, bg = v >> 2, b = bg / NG, g = bg % NG; h = v & 3; is_h = false;
                row0 = b * SEQ + g * NCG * CHUNK; pos0 = g * NCG * CHUNK; nch = NCG; s_in = GSR + (size_t)v * 8192; s_out = nullptr; }
            else if (u < NH1 + NR1 + NHS) { const int v = u - NH1 - NR1, b = v >> 3; h = v & 7; is_h = true;
                row0 = MP + b * DEC_SEQ; pos0 = PAST_LEN; nch = 1; s_in = args.in[3] + (size_t)v * 16384; s_out = args.out + O_HGS + (size_t)v * 16384; }
            else { const int v = u - NH1 - NR1 - NHS, b = v >> 2; h = v & 3; is_h = false;
                row0 = MP + b * DEC_SEQ; pos0 = PAST_LEN; nch = 1; s_in = args.in[4] + (size_t)v * 8192; s_out = args.out + O_RTS + (size_t)v * 8192; }
            if (is_h) hgrn_seq<true>(F2, args, h, row0, nch, s_in, s_out, nullptr);
            else ret_seq<true>(F2, args, h, row0, pos0, nch, s_in, s_out);
        }
        if (BOTH(4)) GRID_BAR();
    }

    if (IN(5)) {
        pg8::Gemm g{(const bf16_t*)(args.ws + WS_MIX), (const bf16_t*)(args.ws + WS_WOT), M, D_MODEL, D_MIX};
        pg8::StaticOrder S; S.init(M, D_MODEL, F.G, (int)blockIdx.x);
        pg8::EpiOut E{args.in[0], args.in[1], args.out};
        pg8::gemm_phase<pg8::EpiOut, pg8::StaticOrder, true, true>(F.lds + RING_OFF, g, S, E);
        if (BOTH(5)) GRID_BAR();
    }
    if (IN(6)) {
        const int gw = F.vcu * NWAVES + F.wave, NGW = F.G * NWAVES;
        const GAS f32x4* gr = (const GAS f32x4*)args.in[16] + F.lane;
        for (int m = gw; m < M; m += NGW) {
            GAS f32x4* y = (GAS f32x4*)(args.out + O_YP + (size_t)m * D_MODEL) + F.lane;
            f32x4 v[4]; float s = 0.f;
#pragma unroll
            for (int j = 0; j < 4; ++j) { v[j] = y[64 * j]; s += (v[j].x * v[j].x + v[j].y * v[j].y) + (v[j].z * v[j].z + v[j].w * v[j].w); }
            const float rs = rsqrtf(wave_sum(s) * (1.f / D_MODEL) + EPS);
#pragma unroll
            for (int j = 0; j < 4; ++j) y[64 * j] = v[j] * rs * gr[64 * j];
        }
    }

#undef IN
#undef BOTH
}
__global__ void __launch_bounds__(256) slow_norm_rows(Ptrs P) {
    const int lane = threadIdx.x & 63, gw = (blockIdx.x * 256 + threadIdx.x) >> 6, ngw = (gridDim.x * 256) >> 6;
    bf16_t* XN = (bf16_t*)((unsigned char*)P.out + OB_XN);
    for (int r = gw; r < M + MMEM; r += ngw) {
        const float* src; const float* g;
        if (r < MP) { src = P.in[0] + (size_t)r * D_MODEL; g = P.in[7]; }
        else if (r < M) { src = P.in[1] + (size_t)(r - MP) * D_MODEL; g = P.in[7]; }
        else { src = P.in[2] + (size_t)(r - M) * D_MODEL; g = P.in[12]; }
        float v[16]; float s = 0.f;
#pragma unroll
        for (int j = 0; j < 16; ++j) { v[j] = src[lane + 64 * j]; s += v[j] * v[j]; }
        s = wave_sum(s);
        const float rs = rsqrtf(s * (1.f / D_MODEL) + EPS);
#pragma unroll
        for (int j = 0; j < 16; ++j) XN[(size_t)r * D_MODEL + lane + 64 * j] = (bf16_t)f2bf(v[j] * rs * g[lane + 64 * j]);
    }
}

template <int MODE>
__global__ void __launch_bounds__(256) slow_gemm(Ptrs P, const bf16_t* A, int lda, const float* W, int ldw, int K, int aux) {
    __shared__ float As[16][65];
    __shared__ float Ws[16][65];
    const int tx = threadIdx.x & 15, ty = threadIdx.x >> 4, m0 = blockIdx.y * 64, n0 = blockIdx.x * 64;
    float acc[4][4] = {};
    for (int k0 = 0; k0 < K; k0 += 16) {
        for (int i = threadIdx.x; i < 1024; i += 256) { const int mm = i >> 4, kk = i & 15; As[kk][mm] = bf2f(A[(size_t)(m0 + mm) * lda + k0 + kk]); }
        for (int i = threadIdx.x; i < 1024; i += 256) { const int kk = i >> 6, nn = i & 63; Ws[kk][nn] = W[(size_t)(k0 + kk) * ldw + n0 + nn]; }
        __syncthreads();
#pragma unroll
        for (int kk = 0; kk < 16; ++kk) {
            float a[4], b[4];
#pragma unroll
            for (int i = 0; i < 4; ++i) { a[i] = As[kk][ty * 4 + i]; b[i] = Ws[kk][tx * 4 + i]; }
#pragma unroll
            for (int i = 0; i < 4; ++i)
#pragma unroll
                for (int j = 0; j < 4; ++j) acc[i][j] += a[i] * b[j];
        }
        __syncthreads();
    }
#pragma unroll
    for (int i = 0; i < 4; ++i)
#pragma unroll
        for (int j = 0; j < 4; ++j) {
            const int m = m0 + ty * 4 + i, n = n0 + tx * 4 + j; const float v = acc[i][j];
            if (MODE == 0) { const Route r = route_col(P, n); r.base[(size_t)m * r.pitch + r.col] = (bf16_t)f2bf(r.act ? silu_f(v) : v); }
            else if (MODE == 1) { P.out[(size_t)aux + (size_t)m * 512 + n] = v; }
            else { const float x = (m < MP) ? P.in[0][(size_t)m * D_MODEL + n] : P.in[1][(size_t)(m - MP) * D_MODEL + n]; P.out[O_YP + (size_t)m * D_MODEL + n] = x + v; }
        }
}

__device__ __forceinline__ float block_sum128(float v, float* red) {
    v = wave_sum(v);
    __syncthreads();
    if ((threadIdx.x & 63) == 0) red[threadIdx.x >> 6] = v;
    __syncthreads();
    return red[0] + red[1];
}

__global__ void __launch_bounds__(128) slow_hgrn(Ptrs P) {
    __shared__ float sf[128], sk[128], sq[128], red[2];
    const int s = blockIdx.x / HG_H, h = blockIdx.x % HG_H, tid = threadIdx.x;
    const int row0 = s < BATCH ? s * SEQ : MP + (s - BATCH) * DEC_SEQ, T = s < BATCH ? SEQ : DEC_SEQ;
    const bf16_t *HQ = wsb(P, WS_HQ), *HF = wsb(P, WS_HF), *HI = wsb(P, WS_HI); bf16_t* MIX = wsb(P, WS_MIX);
    const float l0 = P.in[9][h * 128 + tid], l1 = P.in[9][1024 + h * 128 + tid];
    const float lbv = 1.f / (1.f + expf(l1 - l0));
    const float gn = P.in[10][h * 128 + tid];
    float S[128];
    if (s < BATCH) {
#pragma unroll
        for (int d = 0; d < 128; ++d) S[d] = 0.f;
    } else {
        const float* st = P.in[3] + ((size_t)((s - BATCH) * HG_H + h) * 128) * 128;
#pragma unroll
        for (int d = 0; d < 128; ++d) S[d] = st[(size_t)d * 128 + tid];
    }
    for (int t = 0; t < T; ++t) {
        const size_t row = (size_t)(row0 + t);
        const float x = bf2f(HF[row * 1024 + h * 128 + tid]);
        const float e_ = expf(-x), sig = 1.f / (1.f + e_);
        sf[tid] = lbv + (1.f - lbv) * sig; sk[tid] = (1.f - lbv) * e_ * sig; sq[tid] = bf2f(HQ[row * 1024 + h * 128 + tid]);
        const float v = bf2f(HI[row * 1024 + h * 128 + tid]);
        __syncthreads();
        float o = 0.f;
#pragma unroll
        for (int d = 0; d < 128; ++d) { S[d] = sf[d] * S[d] + sk[d] * v; o += sq[d] * S[d]; }
        const float ss = block_sum128(o * o, red);
        const float r = o * rsqrtf(ss * (1.f / 128.f) + EPS) * gn;
        const size_t mi = row * 2048 + h * 128 + tid;
        MIX[mi] = (bf16_t)f2bf(r * bf2f(MIX[mi]));
        __syncthreads();
    }
    float* so = P.out + (s < BATCH ? O_HGP + ((size_t)(s * HG_H + h) * 128) * 128 : O_HGS + ((size_t)((s - BATCH) * HG_H + h) * 128) * 128);
#pragma unroll
    for (int d = 0; d < 128; ++d) so[(size_t)d * 128 + tid] = S[d];
}

__global__ void __launch_bounds__(128) slow_ret(Ptrs P) {
    __shared__ float sQ[64][65], sK[64][65], sc[64][65], red[2];
    const int s = blockIdx.x / RT_H, h = blockIdx.x % RT_H, tid = threadIdx.x;
    const int row0 = s < BATCH ? s * SEQ : MP + (s - BATCH) * DEC_SEQ, T = s < BATCH ? SEQ : DEC_SEQ, pos0 = s < BATCH ? 0 : PAST_LEN;
    const bf16_t *RQ = wsb(P, WS_RQ), *RK = wsb(P, WS_RK), *RV = wsb(P, WS_RV); bf16_t* MIX = wsb(P, WS_MIX);
    const float lg = log1pf(-exp2f(-5.f - (float)h));
    const float gn = P.in[11][h * 128 + tid];
    float R[64];
    if (s < BATCH) {
#pragma unroll
        for (int d = 0; d < 64; ++d) R[d] = 0.f;
    } else {
        const float* st = P.in[4] + ((size_t)((s - BATCH) * RT_H + h) * 64) * 128;
#pragma unroll
        for (int d = 0; d < 64; ++d) R[d] = st[(size_t)d * 128 + tid];
    }
    for (int c = 0; c < T / CHUNK; ++c) {
        const int r0 = row0 + c * CHUNK;
        for (int idx = tid; idx < 64 * 32; idx += 128) {
            const int t = idx >> 5, i = idx & 31;
            const float inv = expf(-(float)i * (1.f / 32.f) * 9.210340371976184f);
            const float ang = (float)(pos0 + c * CHUNK + t) * inv;
            float sn, cs; sincosf(ang, &sn, &cs);
            const size_t b = (size_t)(r0 + t) * 256 + h * 64;
            const float q1 = bf2f(RQ[b + i]), q2 = bf2f(RQ[b + 32 + i]), k1 = bf2f(RK[b + i]) * 0.125f, k2 = bf2f(RK[b + 32 + i]) * 0.125f;
            sQ[t][i] = q1 * cs - q2 * sn; sQ[t][32 + i] = q1 * sn + q2 * cs;
            sK[t][i] = k1 * cs - k2 * sn; sK[t][32 + i] = k1 * sn + k2 * cs;
        }
        float v[64];
#pragma unroll
        for (int j = 0; j < 64; ++j) v[j] = bf2f(RV[(size_t)(r0 + j) * 512 + h * 128 + tid]);
        __syncthreads();
        for (int idx = tid; idx < 64 * 64; idx += 128) {
            const int i = idx >> 6, j = idx & 63; float a = 0.f;
            for (int d = 0; d < 64; ++d) a += sQ[i][d] * sK[j][d];
            sc[i][j] = a * expf(lg * fabsf((float)(i - j)));
        }
        __syncthreads();
        for (int i = 0; i < 64; ++i) {
            float o = 0.f, o2 = 0.f;
#pragma unroll
            for (int j = 0; j < 64; ++j) o += sc[i][j] * v[j];
#pragma unroll
            for (int d = 0; d < 64; ++d) o2 += sQ[i][d] * R[d];
            o += expf(lg * (float)(i + 1)) * o2;
            const float mu = block_sum128(o, red) * (1.f / 128.f);
            const float cc = o - mu;
            const float var = block_sum128(cc * cc, red) * (1.f / 128.f);
            const float r = cc * rsqrtf(var + EPS) * gn;
            const size_t mi = (size_t)(r0 + i) * 2048 + 1024 + h * 128 + tid;
            MIX[mi] = (bf16_t)f2bf(r * bf2f(MIX[mi]));
        }
        const float cd = expf(lg * 64.f);
#pragma unroll
        for (int d = 0; d < 64; ++d) R[d] *= cd;
#pragma unroll
        for (int j = 0; j < 64; ++j) {
            const float w = expf(lg * (float)(63 - j)) * v[j];
#pragma unroll
            for (int d = 0; d < 64; ++d) R[d] += sK[j][d] * w;
        }
        __syncthreads();
    }
    float* so = P.out + (s < BATCH ? O_RTP + ((size_t)(s * RT_H + h) * 64) * 128 : O_RTS + ((size_t)((s - BATCH) * RT_H + h) * 64) * 128);
#pragma unroll
    for (int d = 0; d < 64; ++d) so[(size_t)d * 128 + tid] = R[d];
}

__global__ void __launch_bounds__(256) slow_xattn(Ptrs P) {
    __shared__ float q[128], p[256], red[4];
    const int row = blockIdx.x, h = blockIdx.y, tid = threadIdx.x;
    const bf16_t* XQ = wsb(P, WS_XQ); bf16_t* MIX = wsb(P, WS_MIX);
    const float *Kb, *Vb;
    if (row < MP) { const int b = row / SEQ; Kb = P.out + O_MKP + (size_t)b * N_MEM * 512; Vb = P.out + O_MVP + (size_t)b * N_MEM * 512; }
    else { const int b = (row - MP) / DEC_SEQ; Kb = P.in[5] + (size_t)b * N_MEM * 512; Vb = P.in[6] + (size_t)b * N_MEM * 512; }
    if (tid < 128) q[tid] = bf2f(XQ[(size_t)row * 512 + h * 128 + tid]);
    __syncthreads();
    float sc = 0.f;
    { const float* kr = Kb + (size_t)tid * 512 + h * 128;
      for (int d = 0; d < 128; ++d) sc += q[d] * kr[d]; }
    sc *= 0.08838834764831845f;
    float mx = sc;
#pragma unroll
    for (int o = 1; o < 64; o <<= 1) mx = fmaxf(mx, __shfl_xor(mx, o));
    if ((tid & 63) == 0) red[tid >> 6] = mx;
    __syncthreads();
    mx = fmaxf(fmaxf(red[0], red[1]), fmaxf(red[2], red[3]));
    const float e = expf(sc - mx);
    p[tid] = e;
    float sm = wave_sum(e);
    __syncthreads();
    if ((tid & 63) == 0) red[tid >> 6] = sm;
    __syncthreads();
    sm = (red[0] + red[1]) + (red[2] + red[3]);
    if (tid < 128) {
        float o = 0.f;
        for (int m = 0; m < 256; ++m) o += p[m] * Vb[(size_t)m * 512 + h * 128 + tid];
        o /= sm;
        const size_t mi = (size_t)row * 2048 + 1536 + h * 128 + tid;
        MIX[mi] = (bf16_t)f2bf(o * bf2f(MIX[mi]));
    }
}

__global__ void __launch_bounds__(256) slow_final_norm(Ptrs P) {
    const int lane = threadIdx.x & 63, gw = (blockIdx.x * 256 + threadIdx.x) >> 6, ngw = (gridDim.x * 256) >> 6;
    const float* g = P.in[16];
    for (int r = gw; r < M; r += ngw) {
        float* y = P.out + O_YP + (size_t)r * D_MODEL;
        float v[16]; float s = 0.f;
#pragma unroll
        for (int j = 0; j < 16; ++j) { v[j] = y[lane + 64 * j]; s += v[j] * v[j]; }
        s = wave_sum(s);
        const float rs = rsqrtf(s * (1.f / D_MODEL) + EPS);
#pragma unroll
        for (int j = 0; j < 16; ++j) y[lane + 64 * j] = v[j] * rs * g[lane + 64 * j];
    }
}


extern "C" void kernel_launch(void* const* d_in, const int* in_sizes, int n_in, void* d_out, int out_size, void* d_ws, size_t ws_size, hipStream_t stream) {
    static int grid = 0;
    if (grid == 0) {
        if (n_in != 17 || (size_t)out_size != O_END || ws_size < WS_END) { fprintf(stderr, "kernel_launch: unexpected sizes n_in %d out %d ws %zu\n", n_in, out_size, ws_size); grid = -1; return; }
        int dev = 0, cus = 0, per_cu = 0;
        if (hipGetDevice(&dev) != hipSuccess || hipDeviceGetAttribute(&cus, hipDeviceAttributeMultiprocessorCount, dev) != hipSuccess) { grid = -1; return; }
        if (hipFuncSetAttribute((const void*)mk_fwd, hipFuncAttributeMaxDynamicSharedMemorySize, LDS_BYTES) != hipSuccess) { fprintf(stderr, "kernel_launch: hipFuncSetAttribute failed\n"); grid = -1; return; }
        if (hipOccupancyMaxActiveBlocksPerMultiprocessor(&per_cu, (const void*)mk_fwd, NWAVES * 64, LDS_BYTES) != hipSuccess || per_cu < 1) { fprintf(stderr, "kernel_launch: occupancy query says %d\n", per_cu); per_cu = 1; }
        (void)hipGetLastError();
        grid = cus;
    }
    if (grid < 0) return;
    Ptrs P{};
    for (int i = 0; i < 17; ++i) P.in[i] = (const float*)d_in[i];
    P.out = (float*)d_out; P.ws = (unsigned char*)d_ws;
    Args a{};
    for (int i = 0; i < 17; ++i) a.in[i] = (const float*)d_in[i];
    a.out = (float*)d_out; a.ws = (unsigned char*)d_ws;
    (void)hipMemsetAsync((char*)d_ws + WS_CTL, 0, CTL_ZERO_BYTES, stream);

    a.ph_lo = 0; a.ph_hi = 7; a.li = 0;
    hipLaunchKernelGGL(mk_fwd, dim3(grid), dim3(NWAVES * 64), LDS_BYTES, stream, a);

}
```

```cpp
#include <hip/hip_runtime.h>
#include <cstdio>
#include <cstdint>

typedef unsigned short bf16_t;

constexpr int D_MODEL = 1024, BATCH = 2, SEQ = 8192, DEC_BATCH = 32, DEC_SEQ = 64, PAST_LEN = 4096, CHUNK = 64, N_MEM = 256;
constexpr int HG_H = 8, HG_DK = 128, HG_DV = 128, RT_H = 4, RT_DK = 64, RT_DV = 128, XA_H = 4, XA_DH = 128;
constexpr int D_IN = 6656, D_MIX = 2048;
constexpr int MP = BATCH * SEQ;
constexpr int MS = DEC_BATCH * DEC_SEQ;
constexpr int M = MP + MS;
constexpr int MMEM = BATCH * N_MEM;
constexpr int NSEQ = BATCH + DEC_BATCH;
constexpr float EPS = 1e-6f;
constexpr int NCG = 4;
constexpr int NG = SEQ / CHUNK / NCG;

constexpr size_t MiB = 1u << 20;
constexpr size_t WS_CTL = 0, CTL_ZERO_BYTES = 1 * MiB;
constexpr size_t WS_HQ = 1 * MiB, WS_HF = 37 * MiB, WS_HI = 73 * MiB, WS_MIX = 109 * MiB, WS_RQ = 181 * MiB, WS_RK = 190 * MiB, WS_RV = 199 * MiB, WS_XQ = 217 * MiB;
constexpr size_t WS_WT = 235 * MiB, WS_WOT = 250 * MiB, WS_ROPE = 254 * MiB, WS_END = 256 * MiB;
constexpr size_t O_YP = 0, O_YS = (size_t)MP * D_MODEL, O_HGP = O_YS + (size_t)MS * D_MODEL, O_RTP = O_HGP + (size_t)BATCH * HG_H * HG_DK * HG_DV,
                 O_MKP = O_RTP + (size_t)BATCH * RT_H * RT_DK * RT_DV, O_MVP = O_MKP + (size_t)BATCH * N_MEM * 512, O_HGS = O_MVP + (size_t)BATCH * N_MEM * 512,
                 O_RTS = O_HGS + (size_t)DEC_BATCH * HG_H * HG_DK * HG_DV, O_END = O_RTS + (size_t)DEC_BATCH * RT_H * RT_DK * RT_DV;
constexpr size_t OB_XN = 0;
constexpr size_t OB_GSH = 0;
constexpr size_t OB_GSR = OB_GSH + (size_t)BATCH * NG * HG_H * 128 * 128 * 4;
constexpr size_t OB_GDH = OB_GSR + (size_t)BATCH * NG * RT_H * 64 * 128 * 4;
constexpr size_t OB_SCR_END = OB_GDH + (size_t)BATCH * NG * HG_H * 128 * 4;
static_assert(OB_SCR_END <= (size_t)M * D_MODEL * 4, "group-state scratch fits the y region");

__device__ __forceinline__ unsigned f2bf(float f) { unsigned u = __builtin_bit_cast(unsigned, f); return (u + 0x7fffu + ((u >> 16) & 1u)) >> 16; }
__device__ __forceinline__ unsigned pk2(float lo, float hi) { unsigned r; asm volatile("v_cvt_pk_bf16_f32 %0, %1, %2" : "=v"(r) : "v"(lo), "v"(hi)); return r; }
__device__ __forceinline__ float bf2f(bf16_t h) { return __builtin_bit_cast(float, (unsigned)h << 16); }
__device__ __forceinline__ float bflo(unsigned w) { return __builtin_bit_cast(float, w << 16); }
__device__ __forceinline__ float bfhi(unsigned w) { return __builtin_bit_cast(float, w & 0xffff0000u); }
__device__ __forceinline__ float silu_f(float x) { return x / (1.f + __expf(-x)); }

struct Ptrs {
    const float* in[17]; float* out; unsigned char* ws;
};
__device__ __forceinline__ bf16_t* wsb(const Ptrs& P, size_t off) { return (bf16_t*)(P.ws + off); }

struct Route { bf16_t* base; int pitch; int col; int act; };
__device__ __forceinline__ Route route_col(unsigned char* ws, int n) {
    Route r;
    if (n < 1024)      { r.base = (bf16_t*)(ws + WS_HQ);  r.pitch = 1024; r.col = n;               r.act = 1; }
    else if (n < 2048) { r.base = (bf16_t*)(ws + WS_HF);  r.pitch = 1024; r.col = n - 1024;        r.act = 0; }
    else if (n < 3072) { r.base = (bf16_t*)(ws + WS_HI);  r.pitch = 1024; r.col = n - 2048;        r.act = 0; }
    else if (n < 4096) { r.base = (bf16_t*)(ws + WS_MIX); r.pitch = 2048; r.col = n - 3072;        r.act = 1; }
    else if (n < 4352) { r.base = (bf16_t*)(ws + WS_RQ);  r.pitch = 256;  r.col = n - 4096;        r.act = 0; }
    else if (n < 4608) { r.base = (bf16_t*)(ws + WS_RK);  r.pitch = 256;  r.col = n - 4352;        r.act = 0; }
    else if (n < 5120) { r.base = (bf16_t*)(ws + WS_RV);  r.pitch = 512;  r.col = n - 4608;        r.act = 0; }
    else if (n < 5632) { r.base = (bf16_t*)(ws + WS_MIX); r.pitch = 2048; r.col = 1024 + n - 5120; r.act = 1; }
    else if (n < 6144) { r.base = (bf16_t*)(ws + WS_XQ);  r.pitch = 512;  r.col = n - 5632;        r.act = 0; }
    else               { r.base = (bf16_t*)(ws + WS_MIX); r.pitch = 2048; r.col = 1536 + n - 6144; r.act = 1; }
    return r;
}
__device__ __forceinline__ Route route_col(const Ptrs& P, int n) { return route_col(P.ws, n); }

__device__ __forceinline__ float wave_sum(float v) {
#pragma unroll
    for (int o = 1; o < 64; o <<= 1) v += __shfl_xor(v, o);
    return v;
}

namespace pg8 {
#define PG8_LAS __attribute__((address_space(3)))
typedef unsigned short bf16_t;
typedef short bf16x8 __attribute__((ext_vector_type(8)));
typedef float f32x4 __attribute__((ext_vector_type(4)));
typedef unsigned u32x4 __attribute__((ext_vector_type(4)));
constexpr int BM = 256, BK = 64, HALF = 128, HTB = HALF * BK * 2  , STAGE_BYTES = 8 * HTB, NXCD = 8, WGM = 8;

__host__ __device__ __forceinline__ int lds_byte(int r, int c) { const int st = (r >> 4) * 2 + (c >> 5), rr = r & 15, cc = c & 31, ob = rr * 64 + cc * 2; return st * 1024 + (ob ^ (((ob >> 9) & 1) << 5)); }
__host__ __device__ __forceinline__ void stage_rc(int b, int& R, int& C) { const int st = b / 1024, sb = b % 1024, swz = sb ^ (((sb >> 9) & 1) << 5); R = (st >> 1) * 16 + swz / 64; C = (st & 1) * 32 + (swz % 64) / 2; }
__host__ __device__ __forceinline__ int perm32(int rho) { const int n = rho >> 4, i = rho & 15; return 8 * (i >> 2) + 4 * n + (i & 3); }

struct Unit { int pm, pn; };
struct Gemm { const bf16_t* A; const bf16_t* Bt; int M, N, K; };

struct StaticOrder {
    int nM, nN, nwg, G, c;
    __host__ __device__ void init(int M, int N, int G_, int c_) { nM = M / BM; nN = N / BM; nwg = nM * nN; G = G_; c = c_; }
    __host__ __device__ bool next(int i, Unit& u) const {
        const long L = (long)i * G + c; if (L >= nwg) return false;
        int wgid = (int)L; { const int q = nwg / NXCD, r = nwg % NXCD, xcd = wgid % NXCD, off = wgid / NXCD; wgid = (xcd < r ? xcd * (q + 1) : r * (q + 1) + (xcd - r) * q) + off; }
        const int nig = WGM * nN, gid = wgid / nig, fm = gid * WGM, gsz = (nM - fm) < WGM ? (nM - fm) : WGM;
        u.pm = fm + ((wgid % nig) % gsz); u.pn = (wgid % nig) / gsz; return true;
    }
    __device__ __forceinline__ void a_ready(const Unit&) const {}
    __device__ __forceinline__ void done(const Unit&) const {}
};
struct ProjOrder {
    StaticOrder so; int G, c;
    __device__ void init(int G_, int c_) { so.init(M, D_IN, G_, c_); G = G_; c = c_; }
    __device__ bool next(int i, Unit& u) const {
        const long L = (long)i * G + c;
        if (L < so.nwg) return so.next(i, u);
        const int k = (int)(L - so.nwg); if (k >= 8) return false;
        u.pm = 72 + (k >> 2); u.pn = 26 + (k & 3); return true;
    }
    __device__ __forceinline__ void a_ready(const Unit&) const {}
    __device__ __forceinline__ void done(const Unit&) const {}
};
__device__ __forceinline__ float fast_silu(float v) { return v * __builtin_amdgcn_rcpf(1.f + __expf(-v)); }
__device__ __forceinline__ unsigned cvt_pk_bf16(float lo, float hi) { unsigned r; asm volatile("v_cvt_pk_bf16_f32 %0, %1, %2" : "=v"(r) : "v"(lo), "v"(hi)); return r; }
struct EpiProj {
    static constexpr bool PERM = true, AFTER_DRAIN = false;
    unsigned char* ws; float* out;
    __device__ __forceinline__ void operator()(const f32x4 (&acc)[2][2][4][2], const Unit& u, int wr, int wc, int fr, int fq) const {
        const int row0 = u.pm * BM + wr * 64 + fr;
        if (u.pn >= 26) {
            const int t = u.pn - 26;
            float* base = out + (t < 2 ? O_MKP : O_MVP) + (t & 1) * 256 + wc * 32 + 8 * fq;
            const int mrow0 = row0 - M;
#pragma unroll
            for (int ai = 0; ai < 2; ++ai)
#pragma unroll
                for (int m = 0; m < 4; ++m) { float* rowp = base + (size_t)(mrow0 + ai * HALF + m * 16) * 512;
#pragma unroll
                    for (int bj = 0; bj < 2; ++bj) { *(f32x4*)(rowp + bj * HALF) = acc[ai][bj][m][0]; *(f32x4*)(rowp + bj * HALF + 4) = acc[ai][bj][m][1]; } }
            return;
        }
        const Route r = route_col(ws, u.pn * BM);
        bf16_t* base = r.base + r.col + wc * 32 + 8 * fq;
#pragma unroll
        for (int ai = 0; ai < 2; ++ai)
#pragma unroll
            for (int m = 0; m < 4; ++m) { bf16_t* rowp = base + (size_t)(row0 + ai * HALF + m * 16) * r.pitch;
#pragma unroll
                for (int bj = 0; bj < 2; ++bj) { f32x4 v0 = acc[ai][bj][m][0], v1 = acc[ai][bj][m][1];
                    if (r.act) { v0 = (f32x4){fast_silu(v0[0]), fast_silu(v0[1]), fast_silu(v0[2]), fast_silu(v0[3])}; v1 = (f32x4){fast_silu(v1[0]), fast_silu(v1[1]), fast_silu(v1[2]), fast_silu(v1[3])}; }
                    u32x4 w; w.x = cvt_pk_bf16(v0[0], v0[1]); w.y = cvt_pk_bf16(v0[2], v0[3]); w.z = cvt_pk_bf16(v1[0], v1[1]); w.w = cvt_pk_bf16(v1[2], v1[3]);
                    *(u32x4*)(rowp + bj * HALF) = w; } }
    }
};
struct EpiOut {
    static constexpr bool PERM = false, AFTER_DRAIN = false;
    const float* xp; const float* xs; float* out;
    __device__ __forceinline__ void operator()(const f32x4 (&acc)[2][2][4][2], const Unit& u, int wr, int wc, int fr, int fq) const {
        const int row0 = u.pm * BM + wr * 64 + fr, col0 = u.pn * BM + wc * 32 + 4 * fq;
#pragma unroll
        for (int ai = 0; ai < 2; ++ai)
#pragma unroll
            for (int m = 0; m < 4; ++m) { const int r = row0 + ai * HALF + m * 16;
                const float* xr = (r < MP ? xp + (size_t)r * D_MODEL : xs + (size_t)(r - MP) * D_MODEL) + col0; float* orow = out + O_YP + (size_t)r * D_MODEL + col0;
#pragma unroll
                for (int bj = 0; bj < 2; ++bj)
#pragma unroll
                    for (int n = 0; n < 2; ++n) *(f32x4*)(orow + bj * HALF + n * 16) = *(const f32x4*)(xr + bj * HALF + n * 16) + acc[ai][bj][m][n]; }
    }
};
template <class Epi, class Sched, bool ALIGN_EPI = false, bool SP2 = false>
__device__ __forceinline__ void gemm_phase(PG8_LAS unsigned char* lds, const Gemm g, const Sched& S, const Epi& E) {
    const int tid = threadIdx.x, wid = __builtin_amdgcn_readfirstlane(tid >> 6), lane = tid & 63, wr = wid >> 2, wc = wid & 3, fr = lane & 15, fq = lane >> 4;
    const int K = g.K, nt = K / BK;
    unsigned voffA[2], voffB[2];
#pragma unroll
    for (int i = 0; i < 2; ++i) { int R, C; stage_rc(tid * 16 + i * 8192, R, C); const int Rb = Epi::PERM ? ((R & ~31) + perm32(R & 31)) : R;
        voffA[i] = (unsigned)(R * K + C) * 2u; voffB[i] = (unsigned)(Rb * K + C) * 2u; }
    const size_t kstep = (size_t)(BK * 2);
    const size_t hstep = (size_t)HALF * K * 2;
    const size_t tstep = 2 * hstep;
    const unsigned ldsw = (unsigned)wid * 1024u;
    const int aoff = lds_byte(wr * 64 + fr, fq * 8), boff = lds_byte(wc * 32 + fr, fq * 8);
#define PG8_SA(b, h) (((b) * 2 + (h)) * HTB)
#define PG8_SB(b, h) ((4 + (b) * 2 + (h)) * HTB)
#define PG8_STAGE(bufoff, gbase, voff) do { _Pragma("unroll") for (int _i = 0; _i < 2; ++_i) \
        __builtin_amdgcn_global_load_lds((const unsigned*)((const char*)(gbase) + (voff)[_i]), (PG8_LAS unsigned*)(lds + (bufoff) + ldsw + _i * 8192), 16, 0, 0); } while (0)
#define PG8_LDA(dst, b, h) do { _Pragma("unroll") for (int m = 0; m < 4; ++m) _Pragma("unroll") for (int k = 0; k < 2; ++k) dst[m][k] = *(const PG8_LAS bf16x8*)(lds + PG8_SA(b, h) + aoff + m * 2048 + k * 1024); } while (0)
#define PG8_LDB(dst, b, h) do { _Pragma("unroll") for (int n = 0; n < 2; ++n) _Pragma("unroll") for (int k = 0; k < 2; ++k) dst[n][k] = *(const PG8_LAS bf16x8*)(lds + PG8_SB(b, h) + boff + n * 2048 + k * 1024); } while (0)
#define PG8_MMA(ai, bj, At, Bt) do { __builtin_amdgcn_s_setprio(1); _Pragma("unroll") for (int m = 0; m < 4; ++m) _Pragma("unroll") for (int n = 0; n < 2; ++n) _Pragma("unroll") for (int k = 0; k < 2; ++k) \
        acc[ai][bj][m][n] = __builtin_amdgcn_mfma_f32_16x16x32_bf16(Bt[n][k], At[m][k], acc[ai][bj][m][n], 0, 0, 0); __builtin_amdgcn_s_setprio(0); } while (0)
#define PG8_WAIT_V(n) asm volatile("s_waitcnt vmcnt(" #n ")" ::: "memory")
#define PG8_WAIT_L(n) asm volatile("s_waitcnt lgkmcnt(" #n ")" ::: "memory")
#define PG8_BAR __builtin_amdgcn_s_barrier()
#define PG8_SCHED __builtin_amdgcn_sched_barrier(0)
    Unit cur, nxt; int ui = 0;
    if (!S.next(0, cur)) return;
    f32x4 acc[2][2][4][2];
#pragma unroll
    for (int a = 0; a < 2; ++a)
#pragma unroll
        for (int b = 0; b < 2; ++b)
#pragma unroll
            for (int m = 0; m < 4; ++m)
#pragma unroll
                for (int n = 0; n < 2; ++n) acc[a][b][m][n] = (f32x4){0.f, 0.f, 0.f, 0.f};
    bf16x8 At[4][2], B0[2][2], B1[2][2];
    const char* cA = (const char*)g.A + (size_t)cur.pm * tstep; const char* cB = (const char*)g.Bt + (size_t)cur.pn * tstep;
    S.a_ready(cur);
    if constexpr (SP2) {
        PG8_STAGE(PG8_SB(0, 0), cB, voffB); PG8_STAGE(PG8_SB(0, 1), cB + hstep, voffB); PG8_STAGE(PG8_SA(0, 0), cA, voffA); PG8_STAGE(PG8_SA(0, 1), cA + hstep, voffA);
        if (wr == 1) PG8_BAR;
        PG8_WAIT_V(2); PG8_BAR;
        PG8_STAGE(PG8_SB(1, 0), cB + kstep, voffB); PG8_STAGE(PG8_SA(1, 0), cA + kstep, voffA); PG8_STAGE(PG8_SB(1, 1), cB + hstep + kstep, voffB);
        PG8_WAIT_V(6); PG8_BAR;
    } else {
        PG8_STAGE(PG8_SB(0, 0), cB, voffB); PG8_STAGE(PG8_SA(0, 0), cA, voffA); PG8_STAGE(PG8_SB(0, 1), cB + hstep, voffB); PG8_STAGE(PG8_SA(0, 1), cA + hstep, voffA);
        if (wr == 1) PG8_BAR;
        PG8_WAIT_V(4); PG8_BAR;
        PG8_STAGE(PG8_SB(1, 0), cB + kstep, voffB); PG8_STAGE(PG8_SA(1, 0), cA + kstep, voffA); PG8_STAGE(PG8_SB(1, 1), cB + hstep + kstep, voffB);
        PG8_WAIT_V(6); PG8_BAR;
    }
    for (;;) {
        const bool has_next = S.next(ui + 1, nxt);
        const char* nA = has_next ? (const char*)g.A + (size_t)nxt.pm * tstep : cA; const char* nB = has_next ? (const char*)g.Bt + (size_t)nxt.pn * tstep : cB;
        for (int t = 0; t < nt; t += 2) {
            const bool last = (t == nt - 2);
            const char* a1 = cA + (size_t)(t + 1) * kstep;
            const char* a2 = last ? nA : cA + (size_t)(t + 2) * kstep; const char* b2 = last ? nB : cB + (size_t)(t + 2) * kstep;
            const char* a3 = a2 + kstep; const char* b3 = b2 + kstep;
            if (last && has_next) S.a_ready(nxt);
            if constexpr (SP2) {
            PG8_LDB(B0, 0, 0); PG8_LDB(B1, 0, 1); PG8_SCHED; PG8_LDA(At, 0, 0); PG8_STAGE(PG8_SA(1, 1), a1 + hstep, voffA);
            PG8_WAIT_V(8); PG8_WAIT_L(0); PG8_BAR; PG8_MMA(0, 0, At, B0); PG8_MMA(0, 1, At, B1); PG8_BAR; PG8_SCHED;
            PG8_LDA(At, 0, 1); PG8_STAGE(PG8_SB(0, 0), b2, voffB); PG8_STAGE(PG8_SB(0, 1), b2 + hstep, voffB); PG8_STAGE(PG8_SA(0, 0), a2, voffA);
            PG8_WAIT_V(8); PG8_WAIT_L(0); PG8_BAR; PG8_MMA(1, 0, At, B0); PG8_MMA(1, 1, At, B1); PG8_BAR; PG8_SCHED;
            PG8_LDB(B0, 1, 0); PG8_LDB(B1, 1, 1); PG8_SCHED; PG8_LDA(At, 1, 0); PG8_STAGE(PG8_SA(0, 1), a2 + hstep, voffA);
            PG8_WAIT_V(8); PG8_WAIT_L(0); PG8_BAR; PG8_MMA(0, 0, At, B0); PG8_MMA(0, 1, At, B1); PG8_BAR; PG8_SCHED;
            PG8_LDA(At, 1, 1); PG8_STAGE(PG8_SB(1, 0), b3, voffB); PG8_STAGE(PG8_SB(1, 1), b3 + hstep, voffB); PG8_STAGE(PG8_SA(1, 0), a3, voffA);
            PG8_WAIT_V(8); PG8_WAIT_L(0); PG8_BAR; PG8_MMA(1, 0, At, B0); PG8_MMA(1, 1, At, B1); PG8_BAR; PG8_SCHED;
            } else {
            PG8_LDB(B0, 0, 0); PG8_SCHED; PG8_LDA(At, 0, 0); PG8_STAGE(PG8_SA(1, 1), a1 + hstep, voffA);
            PG8_WAIT_L(8); PG8_BAR; PG8_WAIT_L(0); PG8_MMA(0, 0, At, B0); PG8_BAR; PG8_SCHED;
            PG8_LDB(B1, 0, 1); PG8_STAGE(PG8_SB(0, 0), b2, voffB);
            PG8_BAR; PG8_WAIT_L(0); PG8_MMA(0, 1, At, B1); PG8_BAR;
            PG8_LDA(At, 0, 1); PG8_STAGE(PG8_SA(0, 0), a2, voffA);
            PG8_BAR; PG8_WAIT_L(0); PG8_MMA(1, 0, At, B0); PG8_BAR; PG8_SCHED;
            PG8_STAGE(PG8_SB(0, 1), b2 + hstep, voffB);
            PG8_WAIT_V(6); PG8_BAR; PG8_MMA(1, 1, At, B1); PG8_BAR;
            PG8_LDB(B0, 1, 0); PG8_SCHED; PG8_LDA(At, 1, 0); PG8_STAGE(PG8_SA(0, 1), a2 + hstep, voffA);
            PG8_WAIT_L(8); PG8_BAR; PG8_WAIT_L(0); PG8_MMA(0, 0, At, B0); PG8_BAR; PG8_SCHED;
            PG8_LDB(B1, 1, 1); PG8_STAGE(PG8_SB(1, 0), b3, voffB);
            PG8_BAR; PG8_WAIT_L(0); PG8_MMA(0, 1, At, B1); PG8_BAR;
            PG8_LDA(At, 1, 1); PG8_STAGE(PG8_SA(1, 0), a3, voffA);
            PG8_BAR; PG8_WAIT_L(0); PG8_MMA(1, 0, At, B0); PG8_BAR; PG8_SCHED;
            PG8_STAGE(PG8_SB(1, 1), b3 + hstep, voffB);
            PG8_WAIT_V(6); PG8_BAR; PG8_MMA(1, 1, At, B1); PG8_BAR;
            }
        }
        if constexpr (ALIGN_EPI) { if (wr == 0) PG8_BAR; }
        if constexpr (!Epi::AFTER_DRAIN) { E(acc, cur, wr, wc, fr, fq); S.done(cur); }
        if (!has_next) break;
#pragma unroll
        for (int a = 0; a < 2; ++a)
#pragma unroll
            for (int b = 0; b < 2; ++b)
#pragma unroll
                for (int m = 0; m < 4; ++m)
#pragma unroll
                    for (int n = 0; n < 2; ++n) acc[a][b][m][n] = (f32x4){0.f, 0.f, 0.f, 0.f};
        cur = nxt; cA = nA; cB = nB; ++ui;
        if constexpr (ALIGN_EPI) { if (wr == 1) PG8_BAR; }
    }
    PG8_WAIT_V(0);
    if constexpr (!ALIGN_EPI) { if (wr == 0) PG8_BAR; }
    PG8_BAR;
    if constexpr (Epi::AFTER_DRAIN) { E.fused(acc, cur, wr, wc, fr, fq, lds, wid, lane); S.done(cur); }
#undef PG8_SA
#undef PG8_SB
#undef PG8_STAGE
#undef PG8_LDA
#undef PG8_LDB
#undef PG8_MMA
#undef PG8_WAIT_V
#undef PG8_WAIT_L
#undef PG8_BAR
#undef PG8_SCHED
}
}
constexpr int NWAVES = 8;
constexpr int RING_OFF = 0, RING_BYTES = 131072;
constexpr int LDS_BYTES = 155648;
constexpr int MISC_OFF = LDS_BYTES - 512;
constexpr int PH_LDS = MISC_OFF;
#define GAS __attribute__((address_space(1)))
#define LAS __attribute__((address_space(3)))
typedef unsigned v4u __attribute__((ext_vector_type(4)));
typedef unsigned v2u __attribute__((ext_vector_type(2)));
typedef float f32x4 __attribute__((ext_vector_type(4)));
typedef float f32x2 __attribute__((ext_vector_type(2)));
typedef short bf16x8 __attribute__((ext_vector_type(8)));
typedef short s16x4 __attribute__((ext_vector_type(4)));
typedef GAS unsigned gu32;
typedef GAS unsigned long long gu64;
#define RLX_AGENT __ATOMIC_RELAXED, __HIP_MEMORY_SCOPE_AGENT
#define LDS_WAIT() asm volatile("s_waitcnt lgkmcnt(0)" ::: "memory")
#define VM_WAIT() asm volatile("s_waitcnt vmcnt(0)" ::: "memory")
constexpr int CW_BAR = 4096;
#define XB_TMO      128
#define XB_XCNT(j)  (256  + 64 * (j))
#define XB_XSUB(j)  (1280 + 64 * (j))
#define XB_XGEN(j)  (2304 + 64 * (j))
#define XB_TOP      3328
#define XB_TOPGEN   3392
#define XCD_BAR_WORDS 3456
#define XB_SPIN_CAP (1u << 18)

__device__ __forceinline__ unsigned xb_ld(unsigned* p)              { return __hip_atomic_load(p, __ATOMIC_RELAXED, __HIP_MEMORY_SCOPE_AGENT); }
__device__ __forceinline__ unsigned xb_add(unsigned* p, unsigned v) { return __hip_atomic_fetch_add(p, v, __ATOMIC_RELAXED, __HIP_MEMORY_SCOPE_AGENT); }
__device__ __forceinline__ unsigned xb_xcc_id() { return (unsigned)__builtin_amdgcn_s_getreg((3 << 11) | 20) & 0xFu; }
#define XB_SPIN(cond, bar) do { unsigned _sp = 0; while (cond) { __builtin_amdgcn_s_sleep(1); \
    if ((++_sp & 255u) == 0u) { if (xb_ld(&(bar)[XB_TMO])) break; if (_sp > XB_SPIN_CAP) { atomicAdd(&(bar)[XB_TMO], 1u); break; } } } } while (0)

struct XcdBarrier {
    unsigned* bar; unsigned x;
    volatile LAS unsigned* st;
};

__device__ __forceinline__ XcdBarrier xcd_barrier_post(unsigned* bar, volatile LAS unsigned* st) {
    XcdBarrier b; b.bar = bar; b.x = xb_xcc_id(); b.st = st;
    if (threadIdx.x == 0) (void)xb_add(&bar[XB_XCNT(b.x)], 1u);
    return b;
}
__device__ __forceinline__ void xcd_barrier_complete(unsigned* bar, unsigned x, unsigned& nloc, unsigned& nx) {
    const unsigned G = gridDim.x * gridDim.y * gridDim.z;
    unsigned sum, cnt, mine, sp = 0u;
    for (;;) {
        sum = 0u; cnt = 0u; mine = 0u;
#pragma unroll
        for (unsigned j = 0; j < 16; ++j) { const unsigned c = xb_ld(&bar[XB_XCNT(j)]); sum += c; cnt += (c > 0u) ? 1u : 0u; mine = (j == x) ? c : mine; }
        if (sum == G) break;
        __builtin_amdgcn_s_sleep(1);
        if ((++sp & 255u) == 0u) { if (xb_ld(&bar[XB_TMO])) break; if (sp > XB_SPIN_CAP) { atomicAdd(&bar[XB_TMO], 1u); break; } }
    }
    nloc = mine > 0u ? mine : 1u; nx = cnt > 0u ? cnt : 1u;
}

__device__ __forceinline__ void xcd_barrier(const XcdBarrier& b) {
    asm volatile("s_waitcnt vmcnt(0)" ::: "memory");
    __syncthreads();
    if (threadIdx.x == 0) {
        unsigned* bar = b.bar;
        __builtin_amdgcn_s_waitcnt(0);
        unsigned nloc = b.st[0], nx = b.st[1];
        if (nloc == 0u) { xcd_barrier_complete(bar, b.x, nloc, nx); b.st[0] = nloc; b.st[1] = nx; }
        const unsigned old = xb_add(&bar[XB_XSUB(b.x)], 1u);
        const unsigned gen = old / nloc;
        if (old + 1u == (gen + 1u) * nloc) {
            __builtin_amdgcn_fence(__ATOMIC_RELEASE, "agent");
            asm volatile("s_waitcnt vmcnt(0)" ::: "memory");
            const unsigned og = xb_add(&bar[XB_TOP], 1u);
            const unsigned tg = og / nx;
            if (og + 1u == (tg + 1u) * nx) xb_add(&bar[XB_TOPGEN], 1u);
            else XB_SPIN(xb_ld(&bar[XB_TOPGEN]) == tg, bar);
            __builtin_amdgcn_fence(__ATOMIC_ACQUIRE, "agent");
            xb_add(&bar[XB_XGEN(b.x)], 1u);
            asm volatile("s_waitcnt vmcnt(0)" ::: "memory");
        } else {
            XB_SPIN(xb_ld(&bar[XB_XGEN(b.x)]) == gen, bar);
            __builtin_amdgcn_fence(__ATOMIC_ACQUIRE, "agent");
            asm volatile("s_waitcnt vmcnt(0)" ::: "memory");
        }
    }
    __syncthreads();
}
struct Args { const float* in[17]; float* out; unsigned char* ws; int ph_lo, ph_hi, li, pad; };
struct Frame {
    LAS unsigned char* lds;
    int tid, lane, wave, vcu, G;
};

__device__ __forceinline__ void p0_transpose_item(const float* W, int K, int N, bf16_t* WT, int row_off, LAS float* scr, int item, int lane) {
    const int nblk = N / 32, kb = item / nblk, nb = item % nblk, k0 = 64 * kb, n0 = 32 * nb;
#pragma unroll 8
    for (int i = 0; i < 32; ++i) { const int kk = 2 * i + (lane >> 5); scr[kk * 33 + (lane & 31)] = W[(size_t)(k0 + kk) * N + n0 + (lane & 31)]; }
    LDS_WAIT(); asm volatile("" ::: "memory");
    const int c = lane & 7;
#pragma unroll
    for (int j = 0; j < 4; ++j) { const int n = (lane >> 3) + 8 * j; const LAS float* s = scr + (8 * c) * 33 + n;
        v4u o; o.x = pk2(s[0 * 33], s[1 * 33]); o.y = pk2(s[2 * 33], s[3 * 33]); o.z = pk2(s[4 * 33], s[5 * 33]); o.w = pk2(s[6 * 33], s[7 * 33]);
        *(GAS v4u*)(WT + (size_t)(row_off + n0 + n) * K + k0 + 8 * c) = o; }
    LDS_WAIT(); asm volatile("" ::: "memory");
}
__device__ __forceinline__ void rms_row_to_bf16(const float* xrow, const float* g, bf16_t* orow, int lane) {
    const GAS f32x4* xr = (const GAS f32x4*)xrow + lane; const GAS f32x4* gr = (const GAS f32x4*)g + lane;
    f32x4 v[4]; float s = 0.f;
#pragma unroll
    for (int j = 0; j < 4; ++j) { v[j] = xr[64 * j]; s += (v[j].x * v[j].x + v[j].y * v[j].y) + (v[j].z * v[j].z + v[j].w * v[j].w); }
    const float rs = rsqrtf(wave_sum(s) * (1.f / D_MODEL) + EPS);
    GAS unsigned long long* o8 = (GAS unsigned long long*)orow + lane;
#pragma unroll
    for (int j = 0; j < 4; ++j) { const f32x4 gg = gr[64 * j];
        o8[64 * j] = (unsigned long long)pk2(v[j].x * rs * gg.x, v[j].y * rs * gg.y) | ((unsigned long long)pk2(v[j].z * rs * gg.z, v[j].w * rs * gg.w) << 32); }
}
__device__ __forceinline__ void p0_prologue(const Frame& F, const Args& A) {
    LAS float* scr = (LAS float*)(F.lds + RING_OFF + F.wave * 16384);
    const int gw = F.vcu * NWAVES + F.wave, NGW = F.G * NWAVES;
    bf16_t* WT = (bf16_t*)(A.ws + WS_WT); bf16_t* WOT = (bf16_t*)(A.ws + WS_WOT);
    constexpr int I_IN = (D_MODEL / 64) * (D_IN / 32), I_MEM = (D_MODEL / 64) * (512 / 32), I_OUT = (D_MIX / 64) * (D_MODEL / 32);
    constexpr int NITEMS = I_IN + 2 * I_MEM + I_OUT;
    for (int it = gw; it < NITEMS; it += NGW) {
        int r = it;
        if (r < I_IN) { p0_transpose_item(A.in[8], D_MODEL, D_IN, WT, 0, scr, r, F.lane); continue; } r -= I_IN;
        if (r < I_MEM) { p0_transpose_item(A.in[13], D_MODEL, 512, WT, D_IN, scr, r, F.lane); continue; } r -= I_MEM;
        if (r < I_MEM) { p0_transpose_item(A.in[14], D_MODEL, 512, WT, D_IN + 512, scr, r, F.lane); continue; } r -= I_MEM;
        p0_transpose_item(A.in[15], D_MIX, D_MODEL, WOT, 0, scr, r, F.lane);
    }
    bf16_t* XN = (bf16_t*)((unsigned char*)A.out + OB_XN);
    for (int m = gw; m < M + MMEM; m += NGW) {
        const float* src; const float* g;
        if (m < MP) { src = A.in[0] + (size_t)m * D_MODEL; g = A.in[7]; }
        else if (m < M) { src = A.in[1] + (size_t)(m - MP) * D_MODEL; g = A.in[7]; }
        else { src = A.in[2] + (size_t)(m - M) * D_MODEL; g = A.in[12]; }
        rms_row_to_bf16(src, g, XN + (size_t)m * D_MODEL, F.lane);
    }
    f32x2* rope = (f32x2*)(A.ws + WS_ROPE);
    for (int idx = F.vcu * (NWAVES * 64) + F.tid; idx < SEQ * 32; idx += F.G * NWAVES * 64) {
        const int pos = idx >> 5, i = idx & 31;
        const float inv = expf(-(float)i * (1.f / 32.f) * 9.210340371976184f);
        float sn, cs; sincosf((float)pos * inv, &sn, &cs);
        rope[idx] = (f32x2){cs, sn};
    }
}

#define MFMA16(a, b, c) __builtin_amdgcn_mfma_f32_16x16x32_bf16((a), (b), (c), 0, 0, 0)
__device__ __forceinline__ bf16x8 ldfrag(const LAS bf16_t* base, int pitch, int row, int k) { return *(const LAS bf16x8*)(base + row * pitch + k); }
__device__ __forceinline__ unsigned cvtpk(float lo, float hi) { unsigned r; asm volatile("v_cvt_pk_bf16_f32 %0, %1, %2" : "=v"(r) : "v"(lo), "v"(hi)); return r; }

constexpr int XA_KP = 136, XA_VP = 264;
constexpr int XA_UNITS_P = BATCH * XA_H * (SEQ / 256), XA_UNITS = XA_UNITS_P + DEC_BATCH * XA_H;
template <bool DRY = false>
__device__ __forceinline__ void xattn_unit(const Frame& F, const Args& A, int unit) {
    LAS bf16_t* Ks = (LAS bf16_t*)(F.lds); LAS bf16_t* VTs = (LAS bf16_t*)(F.lds + 256 * XA_KP * 2);
    int h, row0, ntile; const float *Kb, *Vb;
    if (unit < XA_UNITS_P) { const int rb = unit & 31, bh = unit >> 5, b = bh >> 2; h = bh & 3; row0 = b * SEQ + rb * 256; ntile = 16;
        Kb = A.out + O_MKP + (size_t)b * N_MEM * 512; Vb = A.out + O_MVP + (size_t)b * N_MEM * 512; }
    else { const int u2 = unit - XA_UNITS_P, b = u2 >> 2; h = u2 & 3; row0 = MP + b * DEC_SEQ; ntile = 4;
        Kb = A.in[5] + (size_t)b * N_MEM * 512; Vb = A.in[6] + (size_t)b * N_MEM * 512; }
    const int tid = F.tid, lane = F.lane, w = F.wave, fr = lane & 15, g = lane >> 4;
#pragma unroll 4
    for (int it = 0; it < 16; ++it) { const int idx = it * 512 + tid, m = idx >> 5, c4 = idx & 31;
        const f32x4 v = *(const GAS f32x4*)(Kb + (size_t)m * 512 + h * 128 + 4 * c4);
        *(LAS v2u*)(Ks + m * XA_KP + 4 * c4) = (v2u){pk2(v.x, v.y), pk2(v.z, v.w)}; }
#pragma unroll 2
    for (int it = 0; it < 8; ++it) { const int idx = it * 512 + tid, c4 = idx & 31, mp = idx >> 5;
        const f32x4 v0 = *(const GAS f32x4*)(Vb + (size_t)(2 * mp) * 512 + h * 128 + 4 * c4), v1 = *(const GAS f32x4*)(Vb + (size_t)(2 * mp + 1) * 512 + h * 128 + 4 * c4);
        LAS unsigned* d = (LAS unsigned*)(VTs + (4 * c4) * XA_VP + 2 * mp);
        d[0] = pk2(v0.x, v1.x); d[XA_VP / 2] = pk2(v0.y, v1.y); d[XA_VP] = pk2(v0.z, v1.z); d[3 * (XA_VP / 2)] = pk2(v0.w, v1.w); }
    __syncthreads();
    const bf16_t* XQ = (const bf16_t*)(A.ws + WS_XQ); bf16_t* MIX = (bf16_t*)(A.ws + WS_MIX);
    for (int t = w; t < ntile; t += NWAVES) {
        const int r0 = row0 + 16 * t;
        bf16x8 qf[4];
#pragma unroll
        for (int ks = 0; ks < 4; ++ks) qf[ks] = *(const GAS bf16x8*)(XQ + (size_t)(r0 + fr) * 512 + h * 128 + 32 * ks + 8 * g);
        f32x4 s[16];
#pragma unroll
        for (int nt = 0; nt < 16; ++nt) { f32x4 acc = {0.f, 0.f, 0.f, 0.f};
#pragma unroll
            for (int ks = 0; ks < 4; ++ks) acc = MFMA16(ldfrag(Ks, XA_KP, 16 * nt + fr, 32 * ks + 8 * g), qf[ks], acc);
            s[nt] = acc; }
        float mx = -3.0e38f;
#pragma unroll
        for (int nt = 0; nt < 16; ++nt) mx = fmaxf(fmaxf(mx, fmaxf(s[nt][0], s[nt][1])), fmaxf(s[nt][2], s[nt][3]));
        mx = fmaxf(mx, __shfl_xor(mx, 16)); mx = fmaxf(mx, __shfl_xor(mx, 32));
        const float c = 0.08838834764831845f * 1.4426950408889634f, mc = mx * c;
        float sm = 0.f;
#pragma unroll
        for (int nt = 0; nt < 16; ++nt)
#pragma unroll
            for (int r = 0; r < 4; ++r) { const float p = exp2f(s[nt][r] * c - mc); s[nt][r] = p; sm += p; }
        sm += __shfl_xor(sm, 16); sm += __shfl_xor(sm, 32);
        const float inv = 1.f / sm;
        f32x4 o[8];
#pragma unroll
        for (int et = 0; et < 8; ++et) o[et] = (f32x4){0.f, 0.f, 0.f, 0.f};
#pragma unroll
        for (int s2 = 0; s2 < 8; ++s2) {
            union { bf16x8 v; unsigned u[4]; } pb;
            pb.u[0] = cvtpk(s[2 * s2][0], s[2 * s2][1]); pb.u[1] = cvtpk(s[2 * s2][2], s[2 * s2][3]);
            pb.u[2] = cvtpk(s[2 * s2 + 1][0], s[2 * s2 + 1][1]); pb.u[3] = cvtpk(s[2 * s2 + 1][2], s[2 * s2 + 1][3]);
#pragma unroll
            for (int et = 0; et < 8; ++et) {
                union { bf16x8 v; v2u h2[2]; } va;
                const LAS bf16_t* vp = VTs + (16 * et + fr) * XA_VP + 32 * s2 + 4 * g;
                va.h2[0] = *(const LAS v2u*)vp; va.h2[1] = *(const LAS v2u*)(vp + 16);
                o[et] = MFMA16(va.v, pb.v, o[et]);
            }
        }
#pragma unroll
        for (int et = 0; et < 8; ++et) {
            bf16_t* mp = MIX + (size_t)(r0 + fr) * 2048 + 1536 + h * 128 + 16 * et + 4 * g;
            const v2u gt = *(const GAS v2u*)mp;
            v2u ov; ov.x = pk2(o[et][0] * inv * bflo(gt.x), o[et][1] * inv * bfhi(gt.x)); ov.y = pk2(o[et][2] * inv * bflo(gt.y), o[et][3] * inv * bfhi(gt.y));
            *(GAS v2u*)(DRY ? (bf16_t*)((unsigned char*)A.out + 48 * MiB) + (size_t)(blockIdx.x * 512 + F.tid) * 4 : mp) = ov;
        }
    }
    __syncthreads();
}

constexpr int HP = 136, TP = 72;
constexpr int HG_QS = 0, HG_KS = HG_QS + 64 * HP * 2, HG_KT = HG_KS + 64 * HP * 2, HG_VT = HG_KT + 128 * TP * 2, HG_PS = HG_VT + 128 * TP * 2, HG_ST = HG_PS + 64 * TP * 2,
              HG_SEG = HG_ST + 128 * HP * 2, HG_E1 = HG_SEG + 4 * 128 * 4, HG_E2 = HG_E1 + 512, HG_RED = HG_E2 + 512, HG_END = HG_RED + 8 * 64 * 4;
static_assert(HG_END <= PH_LDS, "hgrn LDS");
template <bool FULL, bool DRY = false>
__device__ __forceinline__ void hgrn_seq(const Frame& F, const Args& A, int h, int row0, int nchunk, const float* s_in, float* s_out, float* gd_out) {
    LAS bf16_t* Qs = (LAS bf16_t*)(F.lds + HG_QS); LAS bf16_t* Ks = (LAS bf16_t*)(F.lds + HG_KS); LAS bf16_t* KTs = (LAS bf16_t*)(F.lds + HG_KT);
    LAS bf16_t* VTs = (LAS bf16_t*)(F.lds + HG_VT); LAS bf16_t* Ps = (LAS bf16_t*)(F.lds + HG_PS); LAS bf16_t* STs = (LAS bf16_t*)(F.lds + HG_ST);
    LAS float* segtot = (LAS float*)(F.lds + HG_SEG); LAS float* E1 = (LAS float*)(F.lds + HG_E1); LAS float* E2 = (LAS float*)(F.lds + HG_E2); LAS float* red = (LAS float*)(F.lds + HG_RED);
    const int tid = F.tid, lane = F.lane, w = F.wave, fr = lane & 15, g = lane >> 4;
    const int d = tid & 127, seg = tid >> 7;
    const bf16_t *HQ = (const bf16_t*)(A.ws + WS_HQ), *HF = (const bf16_t*)(A.ws + WS_HF), *HI = (const bf16_t*)(A.ws + WS_HI); bf16_t* MIX = (bf16_t*)(A.ws + WS_MIX);
    const float lbv = 1.f / (1.f + __expf(A.in[9][1024 + h * 128 + d] - A.in[9][h * 128 + d]));
    f32x4 S[8];
    if (s_in) {
#pragma unroll
        for (int dt = 0; dt < 8; ++dt) { const float* sp = s_in + (size_t)(16 * dt + 4 * g) * 128 + 16 * w + fr; S[dt] = (f32x4){sp[0], sp[128], sp[256], sp[384]}; }
    } else {
#pragma unroll
        for (int dt = 0; dt < 8; ++dt) S[dt] = (f32x4){0.f, 0.f, 0.f, 0.f};
    }
    float gdsum = 0.f;
    const int v_eg = (lane & 3) + 4 * (w >> 1), v_jp = (lane >> 2) + 16 * (w & 1);
    const int l_r = tid >> 4, l_c = 8 * (tid & 15);
    v4u pf[2], pq[2], va, vb;
#define HG_PREFETCH(cc) do { const int r0_ = row0 + (cc) * CHUNK; \
        pf[0] = *(const GAS v4u*)(HF + (size_t)(r0_ + l_r) * 1024 + h * 128 + l_c); pf[1] = *(const GAS v4u*)(HF + (size_t)(r0_ + l_r + 32) * 1024 + h * 128 + l_c); \
        if (FULL) { pq[0] = *(const GAS v4u*)(HQ + (size_t)(r0_ + l_r) * 1024 + h * 128 + l_c); pq[1] = *(const GAS v4u*)(HQ + (size_t)(r0_ + l_r + 32) * 1024 + h * 128 + l_c); } \
        va = *(const GAS v4u*)(HI + (size_t)(r0_ + 2 * v_jp) * 1024 + h * 128 + 8 * v_eg); vb = *(const GAS v4u*)(HI + (size_t)(r0_ + 2 * v_jp + 1) * 1024 + h * 128 + 8 * v_eg); } while (0)
    HG_PREFETCH(0);
    for (int c = 0; c < nchunk; ++c) {
        const int r0 = row0 + c * CHUNK;
        *(LAS v4u*)(Ks + l_r * HP + l_c) = pf[0]; *(LAS v4u*)(Ks + (l_r + 32) * HP + l_c) = pf[1];
        if (FULL) { *(LAS v4u*)(Qs + l_r * HP + l_c) = pq[0]; *(LAS v4u*)(Qs + (l_r + 32) * HP + l_c) = pq[1]; }
        { LAS unsigned* vd = (LAS unsigned*)(VTs + (8 * v_eg) * TP + 2 * v_jp);
          vd[0] = (va.x & 0xffffu) | (vb.x << 16); vd[TP / 2] = (va.x >> 16) | (vb.x & 0xffff0000u); vd[TP] = (va.y & 0xffffu) | (vb.y << 16); vd[3 * (TP / 2)] = (va.y >> 16) | (vb.y & 0xffff0000u);
          vd[2 * TP] = (va.z & 0xffffu) | (vb.z << 16); vd[5 * (TP / 2)] = (va.z >> 16) | (vb.z & 0xffff0000u); vd[3 * TP] = (va.w & 0xffffu) | (vb.w << 16); vd[7 * (TP / 2)] = (va.w >> 16) | (vb.w & 0xffff0000u); }
        __syncthreads();
        if (c + 1 < nchunk) HG_PREFETCH(c + 1);
        float fx[16], qx[16];
#pragma unroll
        for (int t = 0; t < 16; ++t) { fx[t] = bf2f(Ks[(16 * seg + t) * HP + d]); if (FULL) qx[t] = bf2f(Qs[(16 * seg + t) * HP + d]); }
        float kx[16], gc[16]; float run = 0.f;
#pragma unroll
        for (int t = 0; t < 16; ++t) { const float x = fminf(fmaxf(fx[t], -60.f), 60.f), e_ = __expf(-x), sig = __builtin_amdgcn_rcpf(1.f + e_);
            const float f = lbv + (1.f - lbv) * sig; kx[t] = (1.f - lbv) * e_ * sig; run += __logf(f); gc[t] = run; }
        segtot[seg * 128 + d] = run;
        __syncthreads();
        const float t0 = segtot[d], t1 = segtot[128 + d], t2 = segtot[256 + d], t3 = segtot[384 + d];
        const float gref = t0 + t1, gtot = gref + (t2 + t3);
        const float base = (seg == 0 ? 0.f : seg == 1 ? t0 : seg == 2 ? gref : gref + t2) - gref;
        if (seg == 0) { E1[d] = __expf(gref); E2[d] = __expf(gtot - gref); gdsum += gtot; }
        {
            union { v4u v[2]; unsigned short s[16]; } kt;
#pragma unroll
            for (int t = 0; t < 16; t += 2) { const float rel0 = base + gc[t], rel1 = base + gc[t + 1];
                const unsigned kk = pk2(kx[t] * __expf(-rel0), kx[t + 1] * __expf(-rel1)); kt.s[t] = (unsigned short)kk; kt.s[t + 1] = (unsigned short)(kk >> 16);
                if (FULL) { const unsigned qq = pk2(qx[t] * __expf(rel0), qx[t + 1] * __expf(rel1));
                    Ks[(16 * seg + t) * HP + d] = (unsigned short)kk; Ks[(16 * seg + t + 1) * HP + d] = (unsigned short)(kk >> 16);
                    Qs[(16 * seg + t) * HP + d] = (unsigned short)qq; Qs[(16 * seg + t + 1) * HP + d] = (unsigned short)(qq >> 16); } }
            *(LAS v4u*)(KTs + d * TP + 16 * seg) = kt.v[0]; *(LAS v4u*)(KTs + d * TP + 16 * seg + 8) = kt.v[1];
        }
        __syncthreads();
#pragma unroll
        for (int dt = 0; dt < 8; ++dt) { const f32x4 e1 = *(const LAS f32x4*)(E1 + 16 * dt + 4 * g); S[dt] = S[dt] * e1;
            if (FULL) *(LAS v2u*)(STs + (16 * w + fr) * HP + 16 * dt + 4 * g) = (v2u){cvtpk(S[dt][0], S[dt][1]), cvtpk(S[dt][2], S[dt][3])}; }
        if (FULL) {
            const int jt = w & 3;
#pragma unroll
            for (int i2 = 0; i2 < 2; ++i2) { const int it = 2 * (w >> 2) + i2; f32x4 acc = {0.f, 0.f, 0.f, 0.f};
#pragma unroll
                for (int ks = 0; ks < 4; ++ks) acc = MFMA16(ldfrag(Ks, HP, 16 * jt + fr, 32 * ks + 8 * g), ldfrag(Qs, HP, 16 * it + fr, 32 * ks + 8 * g), acc);
                const int i = 16 * it + fr, j0 = 16 * jt + 4 * g;
                *(LAS v2u*)(Ps + i * TP + j0) = (v2u){cvtpk(j0 <= i ? acc[0] : 0.f, j0 + 1 <= i ? acc[1] : 0.f), cvtpk(j0 + 2 <= i ? acc[2] : 0.f, j0 + 3 <= i ? acc[3] : 0.f)}; }
            __syncthreads();
        }
        bf16x8 vt[2];
#pragma unroll
        for (int ks = 0; ks < 2; ++ks) vt[ks] = ldfrag(VTs, TP, 16 * w + fr, 32 * ks + 8 * g);
        f32x4 o[4]; v2u gtp[4];
        if (FULL) {
#pragma unroll
            for (int it = 0; it < 4; ++it) gtp[it] = *(const GAS v2u*)(MIX + (size_t)(r0 + 16 * it + fr) * 2048 + h * 128 + 16 * w + 4 * g);
            bf16x8 st[4];
#pragma unroll
            for (int ks = 0; ks < 4; ++ks) st[ks] = ldfrag(STs, HP, 16 * w + fr, 32 * ks + 8 * g);
#pragma unroll
            for (int it = 0; it < 4; ++it) { f32x4 acc = {0.f, 0.f, 0.f, 0.f};
#pragma unroll
                for (int ks = 0; ks < 2; ++ks) acc = MFMA16(vt[ks], ldfrag(Ps, TP, 16 * it + fr, 32 * ks + 8 * g), acc);
#pragma unroll
                for (int ks = 0; ks < 4; ++ks) acc = MFMA16(st[ks], ldfrag(Qs, HP, 16 * it + fr, 32 * ks + 8 * g), acc);
                o[it] = acc; }
        }
#pragma unroll
        for (int dt = 0; dt < 8; ++dt) {
#pragma unroll
            for (int ks = 0; ks < 2; ++ks) S[dt] = MFMA16(ldfrag(KTs, TP, 16 * dt + fr, 32 * ks + 8 * g), vt[ks], S[dt]);
            const f32x4 e2 = *(const LAS f32x4*)(E2 + 16 * dt + 4 * g); S[dt] = S[dt] * e2; }
        if (FULL) {
#pragma unroll
            for (int it = 0; it < 4; ++it) { float q = (o[it][0] * o[it][0] + o[it][1] * o[it][1]) + (o[it][2] * o[it][2] + o[it][3] * o[it][3]);
                q += __shfl_xor(q, 16); q += __shfl_xor(q, 32);
                if (g == 0) red[w * 64 + 16 * it + fr] = q; }
            __syncthreads();
            const f32x4 gn = *(const GAS f32x4*)(A.in[10] + h * 128 + 16 * w + 4 * g);
#pragma unroll
            for (int it = 0; it < 4; ++it) { const int i = 16 * it + fr; float q = 0.f;
#pragma unroll
                for (int ww = 0; ww < 8; ++ww) q += red[ww * 64 + i];
                const float rs = rsqrtf(q * (1.f / 128.f) + EPS);
                bf16_t* mp = MIX + (size_t)(r0 + i) * 2048 + h * 128 + 16 * w + 4 * g;
                const v2u gt = gtp[it];
                v2u ov; ov.x = pk2(o[it][0] * rs * gn.x * bflo(gt.x), o[it][1] * rs * gn.y * bfhi(gt.x)); ov.y = pk2(o[it][2] * rs * gn.z * bflo(gt.y), o[it][3] * rs * gn.w * bfhi(gt.y));
                *(GAS v2u*)(DRY ? (bf16_t*)((unsigned char*)A.out + 48 * MiB) + (size_t)(blockIdx.x * 512 + tid) * 4 : mp) = ov; }
        } else {
            __syncthreads();
        }
    }
    if (s_out) {
#pragma unroll
        for (int dt = 0; dt < 8; ++dt) { float* sp = s_out + (size_t)(16 * dt + 4 * g) * 128 + 16 * w + fr; sp[0] = S[dt][0]; sp[128] = S[dt][1]; sp[256] = S[dt][2]; sp[384] = S[dt][3]; }
    }
    if (gd_out && seg == 0) gd_out[d] = gdsum;
    __syncthreads();
}

constexpr int RT_RQ = 0, RT_RK = RT_RQ + 64 * TP * 2, RT_KT = RT_RK + 64 * TP * 2, RT_VT = RT_KT + 64 * TP * 2, RT_PS = RT_VT + 128 * TP * 2, RT_RT = RT_PS + 64 * TP * 2,
              RT_GP = RT_RT + 128 * TP * 2, RT_RED = RT_GP + 320, RT_END = RT_RED + 8 * 64 * 2 * 4;
static_assert(RT_END <= PH_LDS, "retention LDS");
template <bool FULL, bool DRY = false>
__device__ __forceinline__ void ret_seq(const Frame& F, const Args& A, int h, int row0, int pos0, int nchunk, const float* s_in, float* s_out) {
    LAS bf16_t* RQs = (LAS bf16_t*)(F.lds + RT_RQ); LAS bf16_t* RKs = (LAS bf16_t*)(F.lds + RT_RK); LAS bf16_t* RKT = (LAS bf16_t*)(F.lds + RT_KT);
    LAS bf16_t* RVT = (LAS bf16_t*)(F.lds + RT_VT); LAS bf16_t* Ps = (LAS bf16_t*)(F.lds + RT_PS); LAS bf16_t* RTs = (LAS bf16_t*)(F.lds + RT_RT);
    LAS float* gpow = (LAS float*)(F.lds + RT_GP); LAS float* red = (LAS float*)(F.lds + RT_RED);
    const int tid = F.tid, lane = F.lane, w = F.wave, fr = lane & 15, g = lane >> 4;
    const bf16_t *RQ = (const bf16_t*)(A.ws + WS_RQ), *RK = (const bf16_t*)(A.ws + WS_RK), *RV = (const bf16_t*)(A.ws + WS_RV); bf16_t* MIX = (bf16_t*)(A.ws + WS_MIX);
    const f32x2* rope = (const f32x2*)(A.ws + WS_ROPE);
    const float lg = log1pf(-exp2f(-5.f - (float)h));
    if (tid < 65) gpow[tid] = expf(lg * (float)tid);
    f32x4 R[4];
    if (s_in) {
#pragma unroll
        for (int dt = 0; dt < 4; ++dt) { const float* sp = s_in + (size_t)(16 * dt + 4 * g) * 128 + 16 * w + fr; R[dt] = (f32x4){sp[0], sp[128], sp[256], sp[384]}; }
    } else {
#pragma unroll
        for (int dt = 0; dt < 4; ++dt) R[dt] = (f32x4){0.f, 0.f, 0.f, 0.f};
    }
    const int e_t = tid >> 3, e_i = 4 * (tid & 7);
    const int v_eg = (lane & 3) + 4 * (w >> 1), v_jp = (lane >> 2) + 16 * (w & 1);
    __syncthreads();
    const float cd = gpow[64];
    v2u pk1, pk2_, pq1, pq2; v4u pva, pvb;
#define RT_PREFETCH(cc) do { const int r0_ = row0 + (cc) * CHUNK; const size_t rb_ = (size_t)(r0_ + e_t) * 256 + h * 64 + e_i; \
        pk1 = *(const GAS v2u*)(RK + rb_); pk2_ = *(const GAS v2u*)(RK + rb_ + 32); if (FULL) { pq1 = *(const GAS v2u*)(RQ + rb_); pq2 = *(const GAS v2u*)(RQ + rb_ + 32); } \
        pva = *(const GAS v4u*)(RV + (size_t)(r0_ + 2 * v_jp) * 512 + h * 128 + 8 * v_eg); pvb = *(const GAS v4u*)(RV + (size_t)(r0_ + 2 * v_jp + 1) * 512 + h * 128 + 8 * v_eg); } while (0)
    RT_PREFETCH(0);
    for (int c = 0; c < nchunk; ++c) {
        const int r0 = row0 + c * CHUNK;
        const v2u k1 = pk1, k2 = pk2_, q1 = pq1, q2 = pq2; const v4u va = pva, vb = pvb;
        if (c + 1 < nchunk) RT_PREFETCH(c + 1);
        {
            const f32x4* rp = (const f32x4*)(rope + (size_t)(pos0 + c * CHUNK + e_t) * 32 + e_i);
            const f32x4 cs01 = rp[0], cs23 = rp[1];
            const float cs[4] = {cs01.x, cs01.z, cs23.x, cs23.z}, sn[4] = {cs01.y, cs01.w, cs23.y, cs23.w};
            const float ka[4] = {bflo(k1.x), bfhi(k1.x), bflo(k1.y), bfhi(k1.y)}, kb[4] = {bflo(k2.x), bfhi(k2.x), bflo(k2.y), bfhi(k2.y)};
            float o1[4], o2[4];
#pragma unroll
            for (int i = 0; i < 4; ++i) { o1[i] = (ka[i] * cs[i] - kb[i] * sn[i]) * 0.125f; o2[i] = (ka[i] * sn[i] + kb[i] * cs[i]) * 0.125f; }
            if (FULL) { *(LAS v2u*)(RKs + e_t * TP + e_i) = (v2u){pk2(o1[0], o1[1]), pk2(o1[2], o1[3])}; *(LAS v2u*)(RKs + e_t * TP + 32 + e_i) = (v2u){pk2(o2[0], o2[1]), pk2(o2[2], o2[3])}; }
            const float kd = gpow[63 - e_t];
#pragma unroll
            for (int i = 0; i < 4; i += 2) { const unsigned a = pk2(o1[i] * kd, o1[i + 1] * kd), b = pk2(o2[i] * kd, o2[i + 1] * kd);
                RKT[(e_i + i) * TP + e_t] = (unsigned short)a; RKT[(e_i + i + 1) * TP + e_t] = (unsigned short)(a >> 16);
                RKT[(32 + e_i + i) * TP + e_t] = (unsigned short)b; RKT[(32 + e_i + i + 1) * TP + e_t] = (unsigned short)(b >> 16); }
            if (FULL) {
                const float qa[4] = {bflo(q1.x), bfhi(q1.x), bflo(q1.y), bfhi(q1.y)}, qb[4] = {bflo(q2.x), bfhi(q2.x), bflo(q2.y), bfhi(q2.y)};
#pragma unroll
                for (int i = 0; i < 4; ++i) { o1[i] = qa[i] * cs[i] - qb[i] * sn[i]; o2[i] = qa[i] * sn[i] + qb[i] * cs[i]; }
                *(LAS v2u*)(RQs + e_t * TP + e_i) = (v2u){pk2(o1[0], o1[1]), pk2(o1[2], o1[3])}; *(LAS v2u*)(RQs + e_t * TP + 32 + e_i) = (v2u){pk2(o2[0], o2[1]), pk2(o2[2], o2[3])};
            }
        }
        {
            LAS unsigned* vd = (LAS unsigned*)(RVT + (8 * v_eg) * TP + 2 * v_jp);
            vd[0] = (va.x & 0xffffu) | (vb.x << 16); vd[TP / 2] = (va.x >> 16) | (vb.x & 0xffff0000u); vd[TP] = (va.y & 0xffffu) | (vb.y << 16); vd[3 * (TP / 2)] = (va.y >> 16) | (vb.y & 0xffff0000u);
            vd[2 * TP] = (va.z & 0xffffu) | (vb.z << 16); vd[5 * (TP / 2)] = (va.z >> 16) | (vb.z & 0xffff0000u); vd[3 * TP] = (va.w & 0xffffu) | (vb.w << 16); vd[7 * (TP / 2)] = (va.w >> 16) | (vb.w & 0xffff0000u);
        }
        if (FULL) {
#pragma unroll
            for (int dt = 0; dt < 4; ++dt) *(LAS v2u*)(RTs + (16 * w + fr) * TP + 16 * dt + 4 * g) = (v2u){cvtpk(R[dt][0], R[dt][1]), cvtpk(R[dt][2], R[dt][3])};
        }
        __syncthreads();
        if (FULL) {
            const int jt = w & 3;
#pragma unroll
            for (int i2 = 0; i2 < 2; ++i2) { const int it = 2 * (w >> 2) + i2; f32x4 acc = {0.f, 0.f, 0.f, 0.f};
#pragma unroll
                for (int ks = 0; ks < 2; ++ks) acc = MFMA16(ldfrag(RKs, TP, 16 * jt + fr, 32 * ks + 8 * g), ldfrag(RQs, TP, 16 * it + fr, 32 * ks + 8 * g), acc);
                const int i = 16 * it + fr, j0 = 16 * jt + 4 * g;
                float pw[4];
#pragma unroll
                for (int r = 0; r < 4; ++r) { const int dd = i - (j0 + r); pw[r] = acc[r] * gpow[dd < 0 ? -dd : dd]; }
                *(LAS v2u*)(Ps + i * TP + j0) = (v2u){cvtpk(pw[0], pw[1]), cvtpk(pw[2], pw[3])}; }
            __syncthreads();
        }
        bf16x8 vt[2];
#pragma unroll
        for (int ks = 0; ks < 2; ++ks) vt[ks] = ldfrag(RVT, TP, 16 * w + fr, 32 * ks + 8 * g);
        f32x4 o[4]; v2u gtp[4];
        if (FULL) {
#pragma unroll
            for (int it = 0; it < 4; ++it) gtp[it] = *(const GAS v2u*)(MIX + (size_t)(r0 + 16 * it + fr) * 2048 + 1024 + h * 128 + 16 * w + 4 * g);
            bf16x8 rt[2];
#pragma unroll
            for (int ks = 0; ks < 2; ++ks) rt[ks] = ldfrag(RTs, TP, 16 * w + fr, 32 * ks + 8 * g);
#pragma unroll
            for (int it = 0; it < 4; ++it) { f32x4 a1 = {0.f, 0.f, 0.f, 0.f}, a2 = {0.f, 0.f, 0.f, 0.f};
#pragma unroll
                for (int ks = 0; ks < 2; ++ks) { a1 = MFMA16(vt[ks], ldfrag(Ps, TP, 16 * it + fr, 32 * ks + 8 * g), a1); a2 = MFMA16(rt[ks], ldfrag(RQs, TP, 16 * it + fr, 32 * ks + 8 * g), a2); }
                o[it] = a1 + a2 * gpow[16 * it + fr + 1]; }
        }
#pragma unroll
        for (int dt = 0; dt < 4; ++dt) { R[dt] = R[dt] * cd;
#pragma unroll
            for (int ks = 0; ks < 2; ++ks) R[dt] = MFMA16(ldfrag(RKT, TP, 16 * dt + fr, 32 * ks + 8 * g), vt[ks], R[dt]); }
        if (FULL) {
#pragma unroll
            for (int it = 0; it < 4; ++it) { float s1 = (o[it][0] + o[it][1]) + (o[it][2] + o[it][3]), s2 = (o[it][0] * o[it][0] + o[it][1] * o[it][1]) + (o[it][2] * o[it][2] + o[it][3] * o[it][3]);
                s1 += __shfl_xor(s1, 16); s1 += __shfl_xor(s1, 32); s2 += __shfl_xor(s2, 16); s2 += __shfl_xor(s2, 32);
                if (g == 0) *(LAS f32x2*)(red + (w * 64 + 16 * it + fr) * 2) = (f32x2){s1, s2}; }
            __syncthreads();
            const f32x4 gn = *(const GAS f32x4*)(A.in[11] + h * 128 + 16 * w + 4 * g);
#pragma unroll
            for (int it = 0; it < 4; ++it) { const int i = 16 * it + fr; float s1 = 0.f, s2 = 0.f;
#pragma unroll
                for (int ww = 0; ww < 8; ++ww) { const f32x2 p = *(const LAS f32x2*)(red + (ww * 64 + i) * 2); s1 += p.x; s2 += p.y; }
                const float mu = s1 * (1.f / 128.f), var = fmaxf(s2 * (1.f / 128.f) - mu * mu, 0.f), rs = rsqrtf(var + EPS);
                bf16_t* mp = MIX + (size_t)(r0 + i) * 2048 + 1024 + h * 128 + 16 * w + 4 * g;
                const v2u gt = gtp[it];
                v2u ov; ov.x = pk2((o[it][0] - mu) * rs * gn.x * bflo(gt.x), (o[it][1] - mu) * rs * gn.y * bfhi(gt.x)); ov.y = pk2((o[it][2] - mu) * rs * gn.z * bflo(gt.y), (o[it][3] - mu) * rs * gn.w * bfhi(gt.y));
                *(GAS v2u*)(DRY ? (bf16_t*)((unsigned char*)A.out + 48 * MiB) + (size_t)(blockIdx.x * 512 + tid) * 4 : mp) = ov; }
        } else {
            __syncthreads();
        }
    }
    if (s_out) {
#pragma unroll
        for (int dt = 0; dt < 4; ++dt) { float* sp = s_out + (size_t)(16 * dt + 4 * g) * 128 + 16 * w + fr; sp[0] = R[dt][0]; sp[128] = R[dt][1]; sp[256] = R[dt][2]; sp[384] = R[dt][3]; }
    }
    __syncthreads();
}

template <bool DRY>
__device__ __forceinline__ void phase2(const Frame& F, const Args& args) {
        float* GSH = (float*)((unsigned char*)args.out + OB_GSH); float* GSR = (float*)((unsigned char*)args.out + OB_GSR); float* GDH = (float*)((unsigned char*)args.out + OB_GDH);
        constexpr int NH1 = BATCH * NG * HG_H, NR1 = BATCH * NG * RT_H;
        for (int u = (int)blockIdx.x; u < XA_UNITS + NH1 + NR1; u += F.G) {
            Frame F2 = F; { int t_ = threadIdx.x; asm volatile("" : "+v"(t_)); F2.tid = t_; F2.lane = t_ & 63; F2.wave = __builtin_amdgcn_readfirstlane(t_ >> 6); }
            if (u < XA_UNITS) xattn_unit<DRY>(F2, args, u);
            else if (u < XA_UNITS + NH1) { const int v = u - XA_UNITS, h = v & 7, bg = v >> 3, b = bg / NG, g = bg % NG;
                hgrn_seq<false, DRY>(F2, args, h, b * SEQ + g * NCG * CHUNK, NCG, nullptr, GSH + (size_t)v * 16384, GDH + (size_t)v * 128); }
            else { const int v = u - XA_UNITS - NH1, h = v & 3, bg = v >> 2, b = bg / NG, g = bg % NG;
                ret_seq<false, DRY>(F2, args, h, b * SEQ + g * NCG * CHUNK, g * NCG * CHUNK, NCG, nullptr, GSR + (size_t)v * 8192); }
        }
}

template <bool DRY>
__device__ __forceinline__ void phase4(const Frame& F, const Args& args) {
        const float* GSH = (const float*)((unsigned char*)args.out + OB_GSH); const float* GSR = (const float*)((unsigned char*)args.out + OB_GSR);
        constexpr int NH1 = BATCH * NG * HG_H, NR1 = BATCH * NG * RT_H, NHS = DEC_BATCH * HG_H, NRS = DEC_BATCH * RT_H;
        for (int u = (int)blockIdx.x; u < NH1 + NR1 + NHS + NRS; u += F.G) {
            Frame F2 = F; { int t_ = threadIdx.x; asm volatile("" : "+v"(t_)); F2.tid = t_; F2.lane = t_ & 63; F2.wave = __builtin_amdgcn_readfirstlane(t_ >> 6); }
            int h, row0, pos0, nch; const float* s_in; float* s_out; bool is_h;
            if (u < NH1) { const int v = u, bg = v >> 3, b = bg / NG, g = bg % NG; h = v & 7; is_h = true;
                row0 = b * SEQ + g * NCG * CHUNK; pos0 = 0; nch = NCG; s_in = GSH + (size_t)v * 16384; s_out = nullptr; }
            else if (u < NH1 + NR1) { const int v = u - NH1, bg = v >> 2, b = bg / NG, g = bg % NG; h = v & 3; is_h = false;
                row0 = b * SEQ + g * NCG * CHUNK; pos0 = g * NCG * CHUNK; nch = NCG; s_in = GSR + (size_t)v * 8192; s_out = nullptr; }
            else if (u < NH1 + NR1 + NHS) { const int v = u - NH1 - NR1, b = v >> 3; h = v & 7; is_h = true;
                row0 = MP + b * DEC_SEQ; pos0 = PAST_LEN; nch = 1; s_in = args.in[3] + (size_t)v * 16384; s_out = args.out + O_HGS + (size_t)v * 16384; }
            else { const int v = u - NH1 - NR1 - NHS, b = v >> 2; h = v & 3; is_h = false;
                row0 = MP + b * DEC_SEQ; pos0 = PAST_LEN; nch = 1; s_in = args.in[4] + (size_t)v * 8192; s_out = args.out + O_RTS + (size_t)v * 8192; }
            if (is_h) hgrn_seq<true, DRY>(F2, args, h, row0, nch, s_in, s_out, nullptr);
            else ret_seq<true, DRY>(F2, args, h, row0, pos0, nch, s_in, s_out);
        }
}

#ifndef MK_GRID_BAR
#define MK_GRID_BAR 1
#endif
__global__ void __launch_bounds__(NWAVES * 64, 2) mk_fwd(Args args) {
    extern __shared__ __attribute__((aligned(16))) unsigned char lds[];
    Frame F;
    F.lds = (LAS unsigned char*)lds;
    F.tid = threadIdx.x; F.lane = F.tid & 63; F.wave = __builtin_amdgcn_readfirstlane(F.tid >> 6);
    F.G = gridDim.x; { const int bx = blockIdx.x; F.vcu = (F.G % 8 == 0) ? (bx % 8) * (F.G / 8) + bx / 8 : bx; }
    volatile LAS unsigned* MISC = (volatile LAS unsigned*)(F.lds + MISC_OFF);
    for (int u = F.tid; u < (LDS_BYTES - MISC_OFF) / 4; u += NWAVES * 64) ((LAS unsigned*)(F.lds + MISC_OFF))[u] = 0u;
    __syncthreads();
    const int lo = args.ph_lo, hi = args.ph_hi;
    unsigned* barw = (unsigned*)(args.ws + WS_CTL) + CW_BAR + args.li * XCD_BAR_WORDS;
    XcdBarrier bar; bar.bar = barw; bar.x = 0; bar.st = nullptr;
    if (hi - lo > 1) bar = xcd_barrier_post(barw, MISC + 8);
#define IN(k) (lo <= (k) && (k) < hi)
#define BOTH(k) (IN(k) && IN((k) + 1))
#define GRID_BAR() xcd_barrier(bar)

    if (IN(0)) { p0_prologue(F, args); if (BOTH(0)) GRID_BAR(); }
    if (IN(1)) {
        pg8::Gemm g{(const bf16_t*)((unsigned char*)args.out + OB_XN), (const bf16_t*)(args.ws + WS_WT), M + MMEM, D_IN + 1024, D_MODEL};
        pg8::ProjOrder S; S.init(F.G, (int)blockIdx.x);
        pg8::EpiProj E{args.ws, args.out};
        pg8::gemm_phase<pg8::EpiProj, pg8::ProjOrder, true, true>(F.lds + RING_OFF, g, S, E);
        if (BOTH(1)) GRID_BAR();
    }
        if (IN(2)) {  phase2<false>(F, args); if (BOTH(2)) GRID_BAR(); }
    if (IN(3)) {
        float* GSH = (float*)((unsigned char*)args.out + OB_GSH); float* GSR = (float*)((unsigned char*)args.out + OB_GSR); const float* GDH = (const float*)((unsigned char*)args.out + OB_GDH);
        const int gt = F.vcu * (NWAVES * 64) + F.tid, NT = F.G * NWAVES * 64;
        for (int idx = gt; idx < BATCH * HG_H * 16384; idx += NT) {
            const int b = idx >> 17, h = (idx >> 14) & 7, de = idx & 16383, d = de >> 7;
            float tv[NG], dv[NG];
#pragma unroll
            for (int g = 0; g < NG; ++g) { const size_t v = (size_t)((b * NG + g) * HG_H + h); tv[g] = GSH[v * 16384 + de]; dv[g] = GDH[v * 128 + d]; }
            float s = 0.f;
#pragma unroll
            for (int g = 0; g < NG; ++g) { const size_t v = (size_t)((b * NG + g) * HG_H + h); GSH[v * 16384 + de] = s; s = __expf(dv[g]) * s + tv[g]; }
            args.out[O_HGP + (size_t)(b * HG_H + h) * 16384 + de] = s;
        }
        for (int idx = gt; idx < BATCH * RT_H * 8192; idx += NT) {
            const int b = idx >> 15, h = (idx >> 13) & 3, de = idx & 8191;
            const float dec = expf(log1pf(-exp2f(-5.f - (float)h)) * (float)(CHUNK * NCG));
            float tv[NG];
#pragma unroll
            for (int g = 0; g < NG; ++g) tv[g] = GSR[(size_t)((b * NG + g) * RT_H + h) * 8192 + de];
            float s = 0.f;
#pragma unroll
            for (int g = 0; g < NG; ++g) { GSR[(size_t)((b * NG + g) * RT_H + h) * 8192 + de] = s; s = dec * s + tv[g]; }
            args.out[O_RTP + (size_t)(b * RT_H + h) * 8192 + de] = s;
        }
        if (BOTH(3)) GRID_BAR();
    }
    if (IN(4)) {  phase4<false>(F, args); if (BOTH(4)) GRID_BAR(); }

    if (IN(5)) {
        pg8::Gemm g{(const bf16_t*)(args.ws + WS_MIX), (const bf16_t*)(args.ws + WS_WOT), M, D_MODEL, D_MIX};
        pg8::StaticOrder S; S.init(M, D_MODEL, F.G, (int)blockIdx.x);
        pg8::EpiOut E{args.in[0], args.in[1], args.out};
        pg8::gemm_phase<pg8::EpiOut, pg8::StaticOrder, true, true>(F.lds + RING_OFF, g, S, E);
        if (BOTH(5)) GRID_BAR();
    }
    if (IN(6)) {
        const int gw = F.vcu * NWAVES + F.wave, NGW = F.G * NWAVES;
        const GAS f32x4* gr = (const GAS f32x4*)args.in[16] + F.lane;
        f32x4 gg[4];
#pragma unroll
        for (int j = 0; j < 4; ++j) gg[j] = gr[64 * j];
        for (int m = gw; m < M; m += 3 * NGW) {
            f32x4 v[3][4];
#pragma unroll
            for (int k = 0; k < 3; ++k) { const int mm = m + k * NGW; if (mm < M) { const GAS f32x4* y = (const GAS f32x4*)(args.out + O_YP + (size_t)mm * D_MODEL) + F.lane;
#pragma unroll
                for (int j = 0; j < 4; ++j) v[k][j] = y[64 * j]; } }
#pragma unroll
            for (int k = 0; k < 3; ++k) { const int mm = m + k * NGW; if (mm < M) { GAS f32x4* y = (GAS f32x4*)(args.out + O_YP + (size_t)mm * D_MODEL) + F.lane; float s = 0.f;
#pragma unroll
                for (int j = 0; j < 4; ++j) s += (v[k][j].x * v[k][j].x + v[k][j].y * v[k][j].y) + (v[k][j].z * v[k][j].z + v[k][j].w * v[k][j].w);
                const float rs = rsqrtf(wave_sum(s) * (1.f / D_MODEL) + EPS);
#pragma unroll
                for (int j = 0; j < 4; ++j) y[64 * j] = v[k][j] * rs * gg[j]; } }
        }
    }

#undef IN
#undef BOTH
}
__global__ void __launch_bounds__(256) slow_norm_rows(Ptrs P) {
    const int lane = threadIdx.x & 63, gw = (blockIdx.x * 256 + threadIdx.x) >> 6, ngw = (gridDim.x * 256) >> 6;
    bf16_t* XN = (bf16_t*)((unsigned char*)P.out + OB_XN);
    for (int r = gw; r < M + MMEM; r += ngw) {
        const float* src; const float* g;
        if (r < MP) { src = P.in[0] + (size_t)r * D_MODEL; g = P.in[7]; }
        else if (r < M) { src = P.in[1] + (size_t)(r - MP) * D_MODEL; g = P.in[7]; }
        else { src = P.in[2] + (size_t)(r - M) * D_MODEL; g = P.in[12]; }
        float v[16]; float s = 0.f;
#pragma unroll
        for (int j = 0; j < 16; ++j) { v[j] = src[lane + 64 * j]; s += v[j] * v[j]; }
        s = wave_sum(s);
        const float rs = rsqrtf(s * (1.f / D_MODEL) + EPS);
#pragma unroll
        for (int j = 0; j < 16; ++j) XN[(size_t)r * D_MODEL + lane + 64 * j] = (bf16_t)f2bf(v[j] * rs * g[lane + 64 * j]);
    }
}

template <int MODE>
__global__ void __launch_bounds__(256) slow_gemm(Ptrs P, const bf16_t* A, int lda, const float* W, int ldw, int K, int aux) {
    __shared__ float As[16][65];
    __shared__ float Ws[16][65];
    const int tx = threadIdx.x & 15, ty = threadIdx.x >> 4, m0 = blockIdx.y * 64, n0 = blockIdx.x * 64;
    float acc[4][4] = {};
    for (int k0 = 0; k0 < K; k0 += 16) {
        for (int i = threadIdx.x; i < 1024; i += 256) { const int mm = i >> 4, kk = i & 15; As[kk][mm] = bf2f(A[(size_t)(m0 + mm) * lda + k0 + kk]); }
        for (int i = threadIdx.x; i < 1024; i += 256) { const int kk = i >> 6, nn = i & 63; Ws[kk][nn] = W[(size_t)(k0 + kk) * ldw + n0 + nn]; }
        __syncthreads();
#pragma unroll
        for (int kk = 0; kk < 16; ++kk) {
            float a[4], b[4];
#pragma unroll
            for (int i = 0; i < 4; ++i) { a[i] = As[kk][ty * 4 + i]; b[i] = Ws[kk][tx * 4 + i]; }
#pragma unroll
            for (int i = 0; i < 4; ++i)
#pragma unroll
                for (int j = 0; j < 4; ++j) acc[i][j] += a[i] * b[j];
        }
        __syncthreads();
    }
#pragma unroll
    for (int i = 0; i < 4; ++i)
#pragma unroll
        for (int j = 0; j < 4; ++j) {
            const int m = m0 + ty * 4 + i, n = n0 + tx * 4 + j; const float v = acc[i][j];
            if (MODE == 0) { const Route r = route_col(P, n); r.base[(size_t)m * r.pitch + r.col] = (bf16_t)f2bf(r.act ? silu_f(v) : v); }
            else if (MODE == 1) { P.out[(size_t)aux + (size_t)m * 512 + n] = v; }
            else { const float x = (m < MP) ? P.in[0][(size_t)m * D_MODEL + n] : P.in[1][(size_t)(m - MP) * D_MODEL + n]; P.out[O_YP + (size_t)m * D_MODEL + n] = x + v; }
        }
}

__device__ __forceinline__ float block_sum128(float v, float* red) {
    v = wave_sum(v);
    __syncthreads();
    if ((threadIdx.x & 63) == 0) red[threadIdx.x >> 6] = v;
    __syncthreads();
    return red[0] + red[1];
}

__global__ void __launch_bounds__(128) slow_hgrn(Ptrs P) {
    __shared__ float sf[128], sk[128], sq[128], red[2];
    const int s = blockIdx.x / HG_H, h = blockIdx.x % HG_H, tid = threadIdx.x;
    const int row0 = s < BATCH ? s * SEQ : MP + (s - BATCH) * DEC_SEQ, T = s < BATCH ? SEQ : DEC_SEQ;
    const bf16_t *HQ = wsb(P, WS_HQ), *HF = wsb(P, WS_HF), *HI = wsb(P, WS_HI); bf16_t* MIX = wsb(P, WS_MIX);
    const float l0 = P.in[9][h * 128 + tid], l1 = P.in[9][1024 + h * 128 + tid];
    const float lbv = 1.f / (1.f + expf(l1 - l0));
    const float gn = P.in[10][h * 128 + tid];
    float S[128];
    if (s < BATCH) {
#pragma unroll
        for (int d = 0; d < 128; ++d) S[d] = 0.f;
    } else {
        const float* st = P.in[3] + ((size_t)((s - BATCH) * HG_H + h) * 128) * 128;
#pragma unroll
        for (int d = 0; d < 128; ++d) S[d] = st[(size_t)d * 128 + tid];
    }
    for (int t = 0; t < T; ++t) {
        const size_t row = (size_t)(row0 + t);
        const float x = bf2f(HF[row * 1024 + h * 128 + tid]);
        const float e_ = expf(-x), sig = 1.f / (1.f + e_);
        sf[tid] = lbv + (1.f - lbv) * sig; sk[tid] = (1.f - lbv) * e_ * sig; sq[tid] = bf2f(HQ[row * 1024 + h * 128 + tid]);
        const float v = bf2f(HI[row * 1024 + h * 128 + tid]);
        __syncthreads();
        float o = 0.f;
#pragma unroll
        for (int d = 0; d < 128; ++d) { S[d] = sf[d] * S[d] + sk[d] * v; o += sq[d] * S[d]; }
        const float ss = block_sum128(o * o, red);
        const float r = o * rsqrtf(ss * (1.f / 128.f) + EPS) * gn;
        const size_t mi = row * 2048 + h * 128 + tid;
        MIX[mi] = (bf16_t)f2bf(r * bf2f(MIX[mi]));
        __syncthreads();
    }
    float* so = P.out + (s < BATCH ? O_HGP + ((size_t)(s * HG_H + h) * 128) * 128 : O_HGS + ((size_t)((s - BATCH) * HG_H + h) * 128) * 128);
#pragma unroll
    for (int d = 0; d < 128; ++d) so[(size_t)d * 128 + tid] = S[d];
}

__global__ void __launch_bounds__(128) slow_ret(Ptrs P) {
    __shared__ float sQ[64][65], sK[64][65], sc[64][65], red[2];
    const int s = blockIdx.x / RT_H, h = blockIdx.x % RT_H, tid = threadIdx.x;
    const int row0 = s < BATCH ? s * SEQ : MP + (s - BATCH) * DEC_SEQ, T = s < BATCH ? SEQ : DEC_SEQ, pos0 = s < BATCH ? 0 : PAST_LEN;
    const bf16_t *RQ = wsb(P, WS_RQ), *RK = wsb(P, WS_RK), *RV = wsb(P, WS_RV); bf16_t* MIX = wsb(P, WS_MIX);
    const float lg = log1pf(-exp2f(-5.f - (float)h));
    const float gn = P.in[11][h * 128 + tid];
    float R[64];
    if (s < BATCH) {
#pragma unroll
        for (int d = 0; d < 64; ++d) R[d] = 0.f;
    } else {
        const float* st = P.in[4] + ((size_t)((s - BATCH) * RT_H + h) * 64) * 128;
#pragma unroll
        for (int d = 0; d < 64; ++d) R[d] = st[(size_t)d * 128 + tid];
    }
    for (int c = 0; c < T / CHUNK; ++c) {
        const int r0 = row0 + c * CHUNK;
        for (int idx = tid; idx < 64 * 32; idx += 128) {
            const int t = idx >> 5, i = idx & 31;
            const float inv = expf(-(float)i * (1.f / 32.f) * 9.210340371976184f);
            const float ang = (float)(pos0 + c * CHUNK + t) * inv;
            float sn, cs; sincosf(ang, &sn, &cs);
            const size_t b = (size_t)(r0 + t) * 256 + h * 64;
            const float q1 = bf2f(RQ[b + i]), q2 = bf2f(RQ[b + 32 + i]), k1 = bf2f(RK[b + i]) * 0.125f, k2 = bf2f(RK[b + 32 + i]) * 0.125f;
            sQ[t][i] = q1 * cs - q2 * sn; sQ[t][32 + i] = q1 * sn + q2 * cs;
            sK[t][i] = k1 * cs - k2 * sn; sK[t][32 + i] = k1 * sn + k2 * cs;
        }
        float v[64];
#pragma unroll
        for (int j = 0; j < 64; ++j) v[j] = bf2f(RV[(size_t)(r0 + j) * 512 + h * 128 + tid]);
        __syncthreads();
        for (int idx = tid; idx < 64 * 64; idx += 128) {
            const int i = idx >> 6, j = idx & 63; float a = 0.f;
            for (int d = 0; d < 64; ++d) a += sQ[i][d] * sK[j][d];
            sc[i][j] = a * expf(lg * fabsf((float)(i - j)));
        }
        __syncthreads();
        for (int i = 0; i < 64; ++i) {
            float o = 0.f, o2 = 0.f;
#pragma unroll
            for (int j = 0; j < 64; ++j) o += sc[i][j] * v[j];
#pragma unroll
            for (int d = 0; d < 64; ++d) o2 += sQ[i][d] * R[d];
            o += expf(lg * (float)(i + 1)) * o2;
            const float mu = block_sum128(o, red) * (1.f / 128.f);
            const float cc = o - mu;
            const float var = block_sum128(cc * cc, red) * (1.f / 128.f);
            const float r = cc * rsqrtf(var + EPS) * gn;
            const size_t mi = (size_t)(r0 + i) * 2048 + 1024 + h * 128 + tid;
            MIX[mi] = (bf16_t)f2bf(r * bf2f(MIX[mi]));
        }
        const float cd = expf(lg * 64.f);
#pragma unroll
        for (int d = 0; d < 64; ++d) R[d] *= cd;
#pragma unroll
        for (int j = 0; j < 64; ++j) {
            const float w = expf(lg * (float)(63 - j)) * v[j];
#pragma unroll
            for (int d = 0; d < 64; ++d) R[d] += sK[j][d] * w;
        }
        __syncthreads();
    }
    float* so = P.out + (s < BATCH ? O_RTP + ((size_t)(s * RT_H + h) * 64) * 128 : O_RTS + ((size_t)((s - BATCH) * RT_H + h) * 64) * 128);
#pragma unroll
    for (int d = 0; d < 64; ++d) so[(size_t)d * 128 + tid] = R[d];
}

__global__ void __launch_bounds__(256) slow_xattn(Ptrs P) {
    __shared__ float q[128], p[256], red[4];
    const int row = blockIdx.x, h = blockIdx.y, tid = threadIdx.x;
    const bf16_t* XQ = wsb(P, WS_XQ); bf16_t* MIX = wsb(P, WS_MIX);
    const float *Kb, *Vb;
    if (row < MP) { const int b = row / SEQ; Kb = P.out + O_MKP + (size_t)b * N_MEM * 512; Vb = P.out + O_MVP + (size_t)b * N_MEM * 512; }
    else { const int b = (row - MP) / DEC_SEQ; Kb = P.in[5] + (size_t)b * N_MEM * 512; Vb = P.in[6] + (size_t)b * N_MEM * 512; }
    if (tid < 128) q[tid] = bf2f(XQ[(size_t)row * 512 + h * 128 + tid]);
    __syncthreads();
    float sc = 0.f;
    { const float* kr = Kb + (size_t)tid * 512 + h * 128;
      for (int d = 0; d < 128; ++d) sc += q[d] * kr[d]; }
    sc *= 0.08838834764831845f;
    float mx = sc;
#pragma unroll
    for (int o = 1; o < 64; o <<= 1) mx = fmaxf(mx, __shfl_xor(mx, o));
    if ((tid & 63) == 0) red[tid >> 6] = mx;
    __syncthreads();
    mx = fmaxf(fmaxf(red[0], red[1]), fmaxf(red[2], red[3]));
    const float e = expf(sc - mx);
    p[tid] = e;
    float sm = wave_sum(e);
    __syncthreads();
    if ((tid & 63) == 0) red[tid >> 6] = sm;
    __syncthreads();
    sm = (red[0] + red[1]) + (red[2] + red[3]);
    if (tid < 128) {
        float o = 0.f;
        for (int m = 0; m < 256; ++m) o += p[m] * Vb[(size_t)m * 512 + h * 128 + tid];
        o /= sm;
        const size_t mi = (size_t)row * 2048 + 1536 + h * 128 + tid;
        MIX[mi] = (bf16_t)f2bf(o * bf2f(MIX[mi]));
    }
}

__global__ void __launch_bounds__(256) slow_final_norm(Ptrs P) {
    const int lane = threadIdx.x & 63, gw = (blockIdx.x * 256 + threadIdx.x) >> 6, ngw = (gridDim.x * 256) >> 6;
    const float* g = P.in[16];
    for (int r = gw; r < M; r += ngw) {
        float* y = P.out + O_YP + (size_t)r * D_MODEL;
        float v[16]; float s = 0.f;
#pragma unroll
        for (int j = 0; j < 16; ++j) { v[j] = y[lane + 64 * j]; s += v[j] * v[j]; }
        s = wave_sum(s);
        const float rs = rsqrtf(s * (1.f / D_MODEL) + EPS);
#pragma unroll
        for (int j = 0; j < 16; ++j) y[lane + 64 * j] = v[j] * rs * g[lane + 64 * j];
    }
}


extern "C" void kernel_launch(void* const* d_in, const int* in_sizes, int n_in, void* d_out, int out_size, void* d_ws, size_t ws_size, hipStream_t stream) {
    static int grid = 0;
    if (grid == 0) {
        if (n_in != 17 || (size_t)out_size != O_END || ws_size < WS_END) { fprintf(stderr, "kernel_launch: unexpected sizes n_in %d out %d ws %zu\n", n_in, out_size, ws_size); grid = -1; return; }
        int dev = 0, cus = 0, per_cu = 0;
        if (hipGetDevice(&dev) != hipSuccess || hipDeviceGetAttribute(&cus, hipDeviceAttributeMultiprocessorCount, dev) != hipSuccess) { grid = -1; return; }
        if (hipFuncSetAttribute((const void*)mk_fwd, hipFuncAttributeMaxDynamicSharedMemorySize, LDS_BYTES) != hipSuccess) { fprintf(stderr, "kernel_launch: hipFuncSetAttribute failed\n"); grid = -1; return; }
        if (hipOccupancyMaxActiveBlocksPerMultiprocessor(&per_cu, (const void*)mk_fwd, NWAVES * 64, LDS_BYTES) != hipSuccess || per_cu < 1) { fprintf(stderr, "kernel_launch: occupancy query says %d\n", per_cu); per_cu = 1; }
        (void)hipGetLastError();
        grid = cus;
    }
    if (grid < 0) return;
    Ptrs P{};
    for (int i = 0; i < 17; ++i) P.in[i] = (const float*)d_in[i];
    P.out = (float*)d_out; P.ws = (unsigned char*)d_ws;
    Args a{};
    for (int i = 0; i < 17; ++i) a.in[i] = (const float*)d_in[i];
    a.out = (float*)d_out; a.ws = (unsigned char*)d_ws;
    (void)hipMemsetAsync((char*)d_ws + WS_CTL, 0, CTL_ZERO_BYTES, stream);

    a.ph_lo = 0; a.ph_hi = 7; a.li = 0;
    hipLaunchKernelGGL(mk_fwd, dim3(grid), dim3(NWAVES * 64), LDS_BYTES, stream, a);

}
```
